# Optimizing an MI355X kernel written in HIP

```python
import functools
import jax, jax.numpy as jnp
from jax import lax
import numpy as np

D_MODEL = 2048
BATCH = 4
SEQ = 2048
DEPTH = 4
DEC_BATCH = 128
DEC_SEQ = 8
PAST_LEN = 16384
PAGE_SIZE = 128

N_META = 16
D_MIX = D_MODEL
D_CONV = D_MIX // 2
CONV_WIDTH = 3
CONV_GROUPS = 8
GLA_HEADS = 4
GLA_DV = (D_MIX - D_CONV) // GLA_HEADS
GLA_DK = GLA_DV // 2
GLA_GATE_RANK = 16
GLA_GATE_TAU = 16.0
GLA_CHUNK = 64
D_FF = 5632
EPS = 1e-6

MIX_IN_SIZES = (D_CONV, D_CONV, D_CONV, GLA_HEADS * GLA_DK, GLA_HEADS * GLA_DK,
                GLA_HEADS * GLA_DV, GLA_HEADS * GLA_DV, GLA_GATE_RANK)
D_MIX_IN = sum(MIX_IN_SIZES)
MIX_IN_OFFSETS = tuple(int(o) for o in np.cumsum(MIX_IN_SIZES)[:-1])

kernel_name = 'hybrid_conv_gla_macaron_step'


def rmsnorm(x, g):
    xf = x.astype(jnp.float32)
    y = xf * lax.rsqrt(jnp.mean(xf * xf, axis=-1, keepdims=True) + EPS)
    return (y * g.astype(jnp.float32)).astype(x.dtype)


def group_rmsnorm(x, g, groups):
    xf = x.astype(jnp.float32)
    xg = xf.reshape(x.shape[:-1] + (groups, x.shape[-1] // groups))
    yg = xg * lax.rsqrt(jnp.mean(xg * xg, axis=-1, keepdims=True) + EPS)
    return (yg.reshape(x.shape) * g.astype(jnp.float32)).astype(x.dtype)


def swiglu(x, w_gu, w_down):
    a, b = jnp.split(x @ w_gu, 2, axis=-1)
    return (jax.nn.silu(a) * b) @ w_down


def gla_chunk(S, q, k, v, g):
    L = q.shape[1]
    b = jnp.cumsum(g, axis=1)
    o_inter = jnp.einsum('blhd,bhdv->blhv', q * jnp.exp(b), S)
    causal = jnp.tril(jnp.ones((L, L), dtype=bool))[None, :, :, None, None]
    decay = jnp.exp(jnp.where(causal, b[:, :, None] - b[:, None, :], -jnp.inf))
    scores = jnp.einsum('bthd,bshd,btshd->bhts', q, k, decay)
    o_intra = jnp.einsum('bhts,bshv->bthv', scores, v)
    b_last = b[:, -1]
    S_new = jnp.exp(b_last)[..., None] * S + jnp.einsum(
        'bshd,bshv->bhdv', k * jnp.exp(b_last[:, None] - b), v)
    return S_new, o_inter + o_intra


def gla_prompt(q, k, v, g):
    Bsz, T = q.shape[:2]
    S0 = jnp.zeros((Bsz, GLA_HEADS, GLA_DK, GLA_DV), jnp.float32)
    S1, o_meta = gla_chunk(S0, q[:, :N_META], k[:, :N_META], v[:, :N_META], g[:, :N_META])
    n_chunks = (T - N_META) // GLA_CHUNK

    def to_chunks(a):
        return a[:, N_META:].reshape((Bsz, n_chunks, GLA_CHUNK) + a.shape[2:]).swapaxes(0, 1)

    S_fin, o_rest = lax.scan(lambda S, xs: gla_chunk(S, *xs), S1,
                             (to_chunks(q), to_chunks(k), to_chunks(v), to_chunks(g)))
    o_rest = o_rest.swapaxes(0, 1).reshape((Bsz, T - N_META) + o_rest.shape[3:])
    return S_fin, jnp.concatenate([o_meta, o_rest], axis=1)


def token_mixer(xn, conv_prev, gla_fn, w_in, conv_w, conv_g, fw2, fb, gla_g, w_out):
    Bsz, T, _ = xn.shape
    f32 = jnp.float32
    cB, cC, ch, q, k, v, go, fl = jnp.split(xn @ w_in, MIX_IN_OFFSETS, axis=-1)
    u = cC * ch
    pad = jnp.concatenate([conv_prev.astype(u.dtype), u], axis=1)
    conv = sum(conv_w[j] * pad[:, j:j + T] for j in range(CONV_WIDTH))
    yc = group_rmsnorm(cB * conv, conv_g, CONV_GROUPS)
    new_conv = pad[:, T:]
    q = q.astype(f32).reshape(Bsz, T, GLA_HEADS, GLA_DK) * (GLA_DK ** -0.5)
    k = k.astype(f32).reshape(Bsz, T, GLA_HEADS, GLA_DK)
    v = v.astype(f32).reshape(Bsz, T, GLA_HEADS, GLA_DV)
    glog = (jax.nn.log_sigmoid((fl @ fw2 + fb).astype(f32)) / GLA_GATE_TAU).reshape(
        Bsz, T, GLA_HEADS, GLA_DK)
    S_new, o = gla_fn(q, k, v, glog)
    o = rmsnorm(o, gla_g) * jax.nn.silu(go.astype(f32).reshape(Bsz, T, GLA_HEADS, GLA_DV))
    yg = o.reshape(Bsz, T, GLA_HEADS * GLA_DV).astype(xn.dtype)
    y = jnp.concatenate([yc, yg], axis=-1) @ w_out
    return y, new_conv, S_new


def decoder_layer(h, conv_prev, gla_fn, p):
    (n1, gu1, dn1, nm, w_in, cw, cg, fw2, fb, gg, w_out, n2, gu2, dn2) = p
    h = h + 0.5 * swiglu(rmsnorm(h, n1), gu1, dn1)
    y, new_conv, S_new = token_mixer(rmsnorm(h, nm), conv_prev, gla_fn, w_in, cw, cg, fw2, fb, gg, w_out)
    h = h + y
    h = h + 0.5 * swiglu(rmsnorm(h, n2), gu2, dn2)
    return h, new_conv, S_new


def setup_inputs(seed: int = 0) -> dict:
    key = jax.random.key(seed)
    ks = jax.random.split(key, 20)

    def nrm(k, shape, scale):
        return jax.random.normal(k, shape, jnp.float32) * scale

    def gain(k, shape):
        return 1.0 + nrm(k, shape, 0.02)

    return {
        'x_prompt': nrm(ks[0], (BATCH, SEQ, D_MODEL), 1.0),
        'x_sample': nrm(ks[1], (DEC_BATCH, DEC_SEQ, D_MODEL), 1.0),
        'state_conv': nrm(ks[2], (DEPTH, DEC_BATCH, CONV_WIDTH - 1, D_CONV), 1.0),
        'state_gla': nrm(ks[3], (DEPTH, DEC_BATCH, GLA_HEADS, GLA_DK, GLA_DV), 0.5),
        'meta_tokens': nrm(ks[4], (N_META, D_MODEL), 1.0),
        'norm_ffn1': gain(ks[5], (DEPTH, D_MODEL)),
        'w_ffn1_gu': nrm(ks[6], (DEPTH, D_MODEL, 2 * D_FF), D_MODEL ** -0.5),
        'w_ffn1_down': nrm(ks[7], (DEPTH, D_FF, D_MODEL), D_FF ** -0.5),
        'norm_mix': gain(ks[8], (DEPTH, D_MODEL)),
        'w_mix_in': nrm(ks[9], (DEPTH, D_MODEL, D_MIX_IN), D_MODEL ** -0.5),
        'conv_w': nrm(ks[10], (DEPTH, CONV_WIDTH, D_CONV), CONV_WIDTH ** -0.5),
        'conv_norm': gain(ks[11], (DEPTH, D_CONV)),
        'gla_fgate_w2': nrm(ks[12], (DEPTH, GLA_GATE_RANK, GLA_HEADS * GLA_DK), GLA_GATE_RANK ** -0.5),
        'gla_fgate_b': nrm(ks[13], (DEPTH, GLA_HEADS * GLA_DK), 0.1),
        'gla_out_norm': gain(ks[14], (DEPTH, GLA_DV)),
        'w_mix_out': nrm(ks[15], (DEPTH, D_MIX, D_MODEL), D_MIX ** -0.5),
        'norm_ffn2': gain(ks[16], (DEPTH, D_MODEL)),
        'w_ffn2_gu': nrm(ks[17], (DEPTH, D_MODEL, 2 * D_FF), D_MODEL ** -0.5),
        'w_ffn2_down': nrm(ks[18], (DEPTH, D_FF, D_MODEL), D_FF ** -0.5),
        'norm_final': gain(ks[19], (D_MODEL,)),
    }


def reference(x_prompt, x_sample, state_conv, state_gla, meta_tokens, norm_ffn1, w_ffn1_gu,
              w_ffn1_down, norm_mix, w_mix_in, conv_w, conv_norm, gla_fgate_w2, gla_fgate_b,
              gla_out_norm, w_mix_out, norm_ffn2, w_ffn2_gu, w_ffn2_down, norm_final):
    bp = x_prompt.shape[0]
    meta = jnp.broadcast_to(meta_tokens.astype(x_prompt.dtype)[None], (bp, N_META, D_MODEL))
    hp = jnp.concatenate([meta, x_prompt], axis=1)
    hs = x_sample
    conv_p, gla_p, conv_s, gla_s = [], [], [], []
    for l in range(DEPTH):
        p = (norm_ffn1[l], w_ffn1_gu[l], w_ffn1_down[l], norm_mix[l], w_mix_in[l], conv_w[l],
             conv_norm[l], gla_fgate_w2[l], gla_fgate_b[l], gla_out_norm[l], w_mix_out[l],
             norm_ffn2[l], w_ffn2_gu[l], w_ffn2_down[l])
        zeros_conv = jnp.zeros((bp, CONV_WIDTH - 1, D_CONV), hp.dtype)
        hp, c_new, S_new = decoder_layer(hp, zeros_conv, gla_prompt, p)
        conv_p.append(c_new)
        gla_p.append(S_new)
        gla_fn_s = functools.partial(gla_chunk, state_gla[l].astype(jnp.float32))
        hs, c_new, S_new = decoder_layer(hs, state_conv[l], gla_fn_s, p)
        conv_s.append(c_new)
        gla_s.append(S_new)
    y_prompt = rmsnorm(hp, norm_final)[:, N_META:]
    y_sample = rmsnorm(hs, norm_final)
    new_gla_prompt = jnp.stack(gla_p)
    new_conv_prompt = jnp.stack(conv_p)
    new_gla_sample = jnp.stack(gla_s)
    new_conv_sample = jnp.stack(conv_s)
    return (y_prompt, y_sample, new_gla_prompt, new_conv_prompt, new_gla_sample, new_conv_sample)
```

```cpp
#include <hip/hip_runtime.h>
#include <cstdio>
#include <cstdint>

#ifndef MK_N_LAUNCHES
#define MK_N_LAUNCHES 1
#endif

__device__ __forceinline__ int fresh_lane() { unsigned z = 0u; asm volatile("" : "+s"(z)); return (int)__builtin_amdgcn_mbcnt_hi(~0u, __builtin_amdgcn_mbcnt_lo(~0u, z)); }
namespace pg8 {
#define PG8_LAS __attribute__((address_space(3)))
#define PG8_GAS __attribute__((address_space(1)))
typedef unsigned short bf16_t;
typedef short bf16x8 __attribute__((ext_vector_type(8)));
typedef float f32x4 __attribute__((ext_vector_type(4)));
typedef unsigned u32x4 __attribute__((ext_vector_type(4)));
constexpr int BM = 256, BK = 64, HALF = 128, HTB = HALF * BK * 2  , STAGE_BYTES = 8 * HTB, NXCD = 8, WGM = 8;

__host__ __device__ __forceinline__ int lds_byte(int r, int c) { const int st = (r >> 4) * 2 + (c >> 5), rr = r & 15, cc = c & 31, ob = rr * 64 + cc * 2; return st * 1024 + (ob ^ (((ob >> 9) & 1) << 5)); }
__host__ __device__ __forceinline__ void stage_rc(int b, int& R, int& C) { const int st = b / 1024, sb = b % 1024, swz = sb ^ (((sb >> 9) & 1) << 5); R = (st >> 1) * 16 + swz / 64; C = (st & 1) * 32 + (swz % 64) / 2; }
__host__ __device__ __forceinline__ int perm32(int rho) { const int n = rho >> 4, i = rho & 15; return 8 * (i >> 2) + 4 * n + (i & 3); }

struct Unit { int pm, pn, kt0, nkt, slab; };
struct Gemm { const bf16_t* A; const bf16_t* Bt; int M, N, K; };

struct StaticOrder {
    int nM, nN, nwg, G, c, nkt;
    __host__ __device__ void init(int M, int N, int K, int G_, int c_) { nM = M / BM; nN = N / BM; nwg = nM * nN; G = G_; c = c_; nkt = K / BK; }
    __host__ __device__ bool next(int i, Unit& u) const {
        const long L = (long)i * G + c; if (L >= nwg) return false;
        u.kt0 = 0; u.nkt = nkt; u.slab = -1;
        int wgid = (int)L; { const int q = nwg / NXCD, r = nwg % NXCD, xcd = wgid % NXCD, off = wgid / NXCD; wgid = (xcd < r ? xcd * (q + 1) : r * (q + 1) + (xcd - r) * q) + off; }
        const int nig = WGM * nN, gid = wgid / nig, fm = gid * WGM, gsz = (nM - fm) < WGM ? (nM - fm) : WGM;
        u.pm = fm + ((wgid % nig) % gsz); u.pn = (wgid % nig) / gsz; return true;
    }
    __device__ __forceinline__ void a_ready(const Unit&) const {}
    __device__ __forceinline__ void done(const Unit&) const {}
};

template <int SP> struct TailSplitOrder : StaticOrder {
    __host__ __device__ int ntail() const { return nwg % G; }
    __host__ __device__ int rounds() const { return nwg / G; }
    __host__ __device__ bool tail_unit(int tu, Unit& u) const { StaticOrder t = *this; t.c = tu; return t.next(rounds(), u); }
    __host__ __device__ bool next(int i, Unit& u) const {
        const int R = rounds(), nt = ntail();
        if (i < R) return StaticOrder::next(i, u);
        if (i > R || nt == 0) return false;
        if (nt * SP > G || (nkt % (2 * SP)) != 0) return StaticOrder::next(i, u);
        if (c >= nt * SP) return false;
        const int tu = c % nt, ks = c / nt;
        if (!tail_unit(tu, u)) return false;
        u.nkt = nkt / SP; u.kt0 = ks * u.nkt; u.slab = tu * SP + ks; return true;
    }
};

template <int SP> struct PanelTailOrder {
    int nM, nN, nwg, G, c, nkt;
    __host__ __device__ __forceinline__ void init(int M, int N, int K, int G_, int c_) { nM = M / BM; nN = N / BM; nwg = nM * nN; G = G_; c = c_; nkt = K / BK; }
    __host__ __device__ __forceinline__ bool fast() const { return G == 256 && nN == 8 && nM > 32 && (nM - 32) * nN * SP <= G && (nkt % (2 * SP)) == 0; }
    __host__ __device__ __forceinline__ int ntail() const { return fast() ? (nM - 32) * nN : 0; }
    __host__ __device__ __forceinline__ bool tail_unit(int tu, Unit& u) const { if (tu >= ntail()) return false; u.pm = 32 + tu / nN; u.pn = tu % nN; u.kt0 = 0; u.nkt = nkt; u.slab = -1; return true; }
    __host__ __device__ __forceinline__ bool next(int i, Unit& u) const {
        if (!fast()) { const long L = (long)i * G + c; if (L >= nwg) return false; u.pm = (int)(L / nN); u.pn = (int)(L % nN); u.kt0 = 0; u.nkt = nkt; u.slab = -1; return true; }
        if (i == 0) { const int x = c & 7, j = c >> 3; u.pm = 4 * x + (j >> 3); u.pn = j & 7; u.kt0 = 0; u.nkt = nkt; u.slab = -1; return true; }
        if (i == 1) { const int nt = ntail(); if (c >= nt * SP) return false; const int tu = c % nt, ks = c / nt; tail_unit(tu, u); u.nkt = nkt / SP; u.kt0 = ks * u.nkt; u.slab = tu * SP + ks; return true; }
        return false;
    }
    __device__ __forceinline__ void a_ready(const Unit&) const {}
    __device__ __forceinline__ void done(const Unit&) const {}
};

typedef __bf16 bf16x2v __attribute__((ext_vector_type(2)));
typedef float f32x2v __attribute__((ext_vector_type(2)));
__device__ __forceinline__ unsigned cvt_pk_bf16(float lo, float hi) { const f32x2v v = {lo, hi}; const bf16x2v r = __builtin_convertvector(v, bf16x2v); return __builtin_bit_cast(unsigned, r); }

struct EpiBf16 {
    static constexpr bool PERM = true, AFTER_DRAIN = false;
    bf16_t* O; int ldc; const float* rs;
    __device__ __forceinline__ static float row_scale(const float* rs, int row) { const f32x4 s0 = ((const PG8_GAS f32x4*)rs)[2 * row], s1 = ((const PG8_GAS f32x4*)rs)[2 * row + 1];
        return 1.0f / sqrtf((((s0[0] + s0[1]) + (s0[2] + s0[3])) + ((s1[0] + s1[1]) + (s1[2] + s1[3]))) * (1.0f / 2048.0f) + 1e-6f); }
    __device__ __forceinline__ void operator()(const f32x4 (&acc)[2][2][4][2], const Unit& u, int wr, int wc, int fr, int fq) const {
        const int row0 = u.pm * BM + wr * 64 + fr; const int col0 = u.pn * BM + wc * 32 + 8 * fq;
#pragma unroll
        for (int ai = 0; ai < 2; ++ai)
#pragma unroll
            for (int m = 0; m < 4; ++m) { PG8_GAS bf16_t* rowp = (PG8_GAS bf16_t*)O + (size_t)(row0 + ai * HALF + m * 16) * ldc + col0; const float r = row_scale(rs, row0 + ai * HALF + m * 16);
#pragma unroll
                for (int bj = 0; bj < 2; ++bj) { const f32x4 v0 = acc[ai][bj][m][0] * r, v1 = acc[ai][bj][m][1] * r;
                    u32x4 w; w.x = cvt_pk_bf16(v0[0], v0[1]); w.y = cvt_pk_bf16(v0[2], v0[3]); w.z = cvt_pk_bf16(v1[0], v1[1]); w.w = cvt_pk_bf16(v1[2], v1[3]);
                    *(PG8_GAS u32x4*)(rowp + bj * HALF) = w; } }
    }
};
struct EpiSwiGLU {
    static constexpr bool PERM = true, AFTER_DRAIN = false;
    bf16_t* O; int ldc; const float* rs;
    __device__ __forceinline__ static float silu_mul(float a, float b) { return a * __builtin_amdgcn_rcpf(1.0f + __builtin_amdgcn_exp2f(-1.44269504089f * a)) * b; }
    __device__ __forceinline__ void operator()(const f32x4 (&acc)[2][2][4][2], const Unit& u, int wr, int wc, int fr, int fq) const {
        const int row0 = u.pm * BM + wr * 64 + fr; const int col0 = u.pn * HALF + wc * 32 + 8 * fq;
#pragma unroll
        for (int ai = 0; ai < 2; ++ai)
#pragma unroll
            for (int m = 0; m < 4; ++m) { PG8_GAS bf16_t* rowp = (PG8_GAS bf16_t*)O + (size_t)(row0 + ai * HALF + m * 16) * ldc + col0;
                const float r = EpiBf16::row_scale(rs, row0 + ai * HALF + m * 16);
                const f32x4 a0 = acc[ai][0][m][0] * r, a1 = acc[ai][0][m][1] * r, b0 = acc[ai][1][m][0] * r, b1 = acc[ai][1][m][1] * r;
                f32x4 e0, e1;
#pragma unroll
                for (int j = 0; j < 4; ++j) { e0[j] = __builtin_amdgcn_exp2f(-1.44269504089f * a0[j]); e1[j] = __builtin_amdgcn_exp2f(-1.44269504089f * a1[j]); }
                f32x4 r0, r1;
#pragma unroll
                for (int j = 0; j < 4; ++j) { r0[j] = __builtin_amdgcn_rcpf(1.0f + e0[j]); r1[j] = __builtin_amdgcn_rcpf(1.0f + e1[j]); }
                const f32x4 s0 = a0 * r0 * b0, s1 = a1 * r1 * b1;
                u32x4 w; w.x = cvt_pk_bf16(s0[0], s0[1]); w.y = cvt_pk_bf16(s0[2], s0[3]); w.z = cvt_pk_bf16(s1[0], s1[1]); w.w = cvt_pk_bf16(s1[2], s1[3]);
                *(PG8_GAS u32x4*)rowp = w; }
    }
};
struct EpiResid {
    static constexpr bool PERM = false, AFTER_DRAIN = false;
    bf16_t* C; int ldc; float scale; float* slabs; float* ssq; PG8_LAS float* red;
    __device__ __forceinline__ void operator()(const f32x4 (&acc)[2][2][4][2], const Unit& u, int wr, int wc, int fr, int fq) const {
        if (u.slab >= 0) {
            typedef unsigned u32x2 __attribute__((ext_vector_type(2)));
            PG8_GAS bf16_t* sp = (PG8_GAS bf16_t*)slabs + (size_t)u.slab * (BM * BM) + (size_t)(wr * 64 + fr) * BM + wc * 32 + 4 * fq;
#pragma unroll
            for (int ai = 0; ai < 2; ++ai)
#pragma unroll
                for (int m = 0; m < 4; ++m)
#pragma unroll
                    for (int bj = 0; bj < 2; ++bj)
#pragma unroll
                        for (int n = 0; n < 2; ++n) { const f32x4 v = acc[ai][bj][m][n]; *(PG8_GAS u32x2*)(sp + (size_t)(ai * HALF + m * 16) * BM + bj * HALF + n * 16) = (u32x2){cvt_pk_bf16(v[0], v[1]), cvt_pk_bf16(v[2], v[3])}; }
            return;
        }
        const int row0 = u.pm * BM + wr * 64 + fr, col0 = u.pn * BM + wc * 32 + 4 * fq;
        typedef unsigned u32x2 __attribute__((ext_vector_type(2)));
#pragma unroll
        for (int ai = 0; ai < 2; ++ai) {
            u32x2 old[4][2][2];
#pragma unroll
            for (int m = 0; m < 4; ++m) { const PG8_GAS bf16_t* rowp = (const PG8_GAS bf16_t*)C + (size_t)(row0 + ai * HALF + m * 16) * ldc + col0;
#pragma unroll
                for (int bj = 0; bj < 2; ++bj)
#pragma unroll
                    for (int n = 0; n < 2; ++n) old[m][bj][n] = *(const PG8_GAS u32x2*)(rowp + bj * HALF + n * 16); }
#pragma unroll
            for (int m = 0; m < 4; ++m) { PG8_GAS bf16_t* rowp = (PG8_GAS bf16_t*)C + (size_t)(row0 + ai * HALF + m * 16) * ldc + col0; float q = 0.f;
#pragma unroll
                for (int bj = 0; bj < 2; ++bj)
#pragma unroll
                    for (int n = 0; n < 2; ++n) { const u32x2 o = old[m][bj][n]; const f32x4 a = acc[ai][bj][m][n];
                        const float y0 = __builtin_bit_cast(float, o.x << 16) + a[0] * scale, y1 = __builtin_bit_cast(float, o.x & 0xffff0000u) + a[1] * scale;
                        const float y2 = __builtin_bit_cast(float, o.y << 16) + a[2] * scale, y3 = __builtin_bit_cast(float, o.y & 0xffff0000u) + a[3] * scale;
                        q += (y0 * y0 + y1 * y1) + (y2 * y2 + y3 * y3);
                        *(PG8_GAS u32x2*)(rowp + bj * HALF + n * 16) = (u32x2){cvt_pk_bf16(y0, y1), cvt_pk_bf16(y2, y3)}; }
                q += __shfl_xor(q, 16, 64); q += __shfl_xor(q, 32, 64); if (fq == 0) red[(wr * 64 + ai * HALF + m * 16 + fr) * 4 + wc] = q; }
        }
        asm volatile("s_waitcnt lgkmcnt(0)" ::: "memory"); __builtin_amdgcn_s_barrier(); asm volatile("" ::: "memory");
        { const int t = (wr * 4 + wc) * 64 + fq * 16 + fr;
          if (t < BM) { const f32x4 q = *(const PG8_LAS f32x4*)(red + t * 4); ((PG8_GAS float*)ssq)[(size_t)(u.pm * BM + t) * 8 + u.pn] = (q[0] + q[1]) + (q[2] + q[3]); } }
    }
};

template <class Epi, class Sched, bool ALIGN_EPI = false, bool SP2 = false>
__device__ __forceinline__ void gemm_phase(PG8_LAS unsigned char* lds, const Gemm g, const Sched& S, const Epi& E, const int wave_id) {
    int tid_ = wave_id * 64 + fresh_lane(); asm volatile("" : "+v"(tid_));
    const int tid = tid_, wid = __builtin_amdgcn_readfirstlane(tid >> 6), lane = tid & 63, wr = wid >> 2, wc = wid & 3, fr = lane & 15, fq = lane >> 4;
    const int K = g.K;
    unsigned voffA[2], voffB[2];
#pragma unroll
    for (int i = 0; i < 2; ++i) { int R, C; stage_rc(tid * 16 + i * 8192, R, C); const int Rb = Epi::PERM ? ((R & ~31) + perm32(R & 31)) : R;
        voffA[i] = (unsigned)(R * K + C) * 2u; voffB[i] = (unsigned)(Rb * K + C) * 2u; }
    const size_t kstep = (size_t)(BK * 2);
    const size_t hstep = (size_t)HALF * K * 2;
    const size_t tstep = 2 * hstep;
    const unsigned ldsw = (unsigned)wid * 1024u;
    const int aoff = lds_byte(wr * 64 + fr, fq * 8), boff = lds_byte(wc * 32 + fr, fq * 8);
#define PG8_SA(b, h) (((b) * 2 + (h)) * HTB)
#define PG8_SB(b, h) ((4 + (b) * 2 + (h)) * HTB)
#define PG8_STAGE(bufoff, gbase, voff) do { _Pragma("unroll") for (int _i = 0; _i < 2; ++_i) \
        __builtin_amdgcn_global_load_lds((const unsigned*)((const char*)(gbase) + (voff)[_i]), (PG8_LAS unsigned*)(lds + (bufoff) + ldsw + _i * 8192), 16, 0, 0); } while (0)
#define PG8_LDA(dst, b, h) do { _Pragma("unroll") for (int m = 0; m < 4; ++m) _Pragma("unroll") for (int k = 0; k < 2; ++k) dst[m][k] = *(const PG8_LAS bf16x8*)(lds + PG8_SA(b, h) + aoff + m * 2048 + k * 1024); } while (0)
#define PG8_LDB(dst, b, h) do { _Pragma("unroll") for (int n = 0; n < 2; ++n) _Pragma("unroll") for (int k = 0; k < 2; ++k) dst[n][k] = *(const PG8_LAS bf16x8*)(lds + PG8_SB(b, h) + boff + n * 2048 + k * 1024); } while (0)
#define PG8_MMA(ai, bj, At, Bt) do { __builtin_amdgcn_s_setprio(1); _Pragma("unroll") for (int m = 0; m < 4; ++m) _Pragma("unroll") for (int n = 0; n < 2; ++n) _Pragma("unroll") for (int k = 0; k < 2; ++k) \
        acc[ai][bj][m][n] = __builtin_amdgcn_mfma_f32_16x16x32_bf16(Bt[n][k], At[m][k], acc[ai][bj][m][n], 0, 0, 0); __builtin_amdgcn_s_setprio(0); } while (0)
#define PG8_WAIT_V(n) asm volatile("s_waitcnt vmcnt(" #n ")" ::: "memory")
#define PG8_WAIT_L(n) asm volatile("s_waitcnt lgkmcnt(" #n ")" ::: "memory")
#define PG8_BAR __builtin_amdgcn_s_barrier()
#define PG8_SCHED __builtin_amdgcn_sched_barrier(0)
    Unit cur, nxt; int ui = 0;
    if (!S.next(0, cur)) return;
    f32x4 acc[2][2][4][2];
#pragma unroll
    for (int a = 0; a < 2; ++a)
#pragma unroll
        for (int b = 0; b < 2; ++b)
#pragma unroll
            for (int m = 0; m < 4; ++m)
#pragma unroll
                for (int n = 0; n < 2; ++n) acc[a][b][m][n] = (f32x4){0.f, 0.f, 0.f, 0.f};
    bf16x8 At[4][2], B0[2][2], B1[2][2];
    const char* cA = (const char*)g.A + (size_t)cur.pm * tstep + (size_t)cur.kt0 * kstep; const char* cB = (const char*)g.Bt + (size_t)cur.pn * tstep + (size_t)cur.kt0 * kstep;
    S.a_ready(cur);
    if constexpr (SP2) {
        PG8_STAGE(PG8_SB(0, 0), cB, voffB); PG8_STAGE(PG8_SB(0, 1), cB + hstep, voffB); PG8_STAGE(PG8_SA(0, 0), cA, voffA); PG8_STAGE(PG8_SA(0, 1), cA + hstep, voffA);
        if (wr == 1) PG8_BAR;
        PG8_WAIT_V(2); PG8_BAR;
        PG8_STAGE(PG8_SB(1, 0), cB + kstep, voffB); PG8_STAGE(PG8_SA(1, 0), cA + kstep, voffA); PG8_STAGE(PG8_SB(1, 1), cB + hstep + kstep, voffB);
        PG8_WAIT_V(6); PG8_BAR;
    } else {
        PG8_STAGE(PG8_SB(0, 0), cB, voffB); PG8_STAGE(PG8_SA(0, 0), cA, voffA); PG8_STAGE(PG8_SB(0, 1), cB + hstep, voffB); PG8_STAGE(PG8_SA(0, 1), cA + hstep, voffA);
        if (wr == 1) PG8_BAR;
        PG8_WAIT_V(4); PG8_BAR;
        PG8_STAGE(PG8_SB(1, 0), cB + kstep, voffB); PG8_STAGE(PG8_SA(1, 0), cA + kstep, voffA); PG8_STAGE(PG8_SB(1, 1), cB + hstep + kstep, voffB);
        PG8_WAIT_V(6); PG8_BAR;
    }
    for (;;) {
        const bool has_next = S.next(ui + 1, nxt);
        const char* nA = has_next ? (const char*)g.A + (size_t)nxt.pm * tstep + (size_t)nxt.kt0 * kstep : cA; const char* nB = has_next ? (const char*)g.Bt + (size_t)nxt.pn * tstep + (size_t)nxt.kt0 * kstep : cB;
        const int nt = cur.nkt;
        for (int t = 0; t < nt; t += 2) {
            const bool last = (t == nt - 2);
            const char* a1 = cA + (size_t)(t + 1) * kstep;
            const char* a2 = last ? nA : cA + (size_t)(t + 2) * kstep; const char* b2 = last ? nB : cB + (size_t)(t + 2) * kstep;
            const char* a3 = a2 + kstep; const char* b3 = b2 + kstep;
            if (last && has_next) S.a_ready(nxt);
            if constexpr (SP2) {
            PG8_LDB(B0, 0, 0); PG8_LDB(B1, 0, 1); PG8_SCHED; PG8_LDA(At, 0, 0); PG8_STAGE(PG8_SA(1, 1), a1 + hstep, voffA);
            PG8_WAIT_V(8); PG8_WAIT_L(0); PG8_BAR; PG8_MMA(0, 0, At, B0); PG8_MMA(0, 1, At, B1); PG8_BAR; PG8_SCHED;
            PG8_LDA(At, 0, 1); PG8_STAGE(PG8_SB(0, 0), b2, voffB); PG8_STAGE(PG8_SB(0, 1), b2 + hstep, voffB); PG8_STAGE(PG8_SA(0, 0), a2, voffA);
            PG8_WAIT_V(8); PG8_WAIT_L(0); PG8_BAR; PG8_MMA(1, 0, At, B0); PG8_MMA(1, 1, At, B1); PG8_BAR; PG8_SCHED;
            PG8_LDB(B0, 1, 0); PG8_LDB(B1, 1, 1); PG8_SCHED; PG8_LDA(At, 1, 0); PG8_STAGE(PG8_SA(0, 1), a2 + hstep, voffA);
            PG8_WAIT_V(8); PG8_WAIT_L(0); PG8_BAR; PG8_MMA(0, 0, At, B0); PG8_MMA(0, 1, At, B1); PG8_BAR; PG8_SCHED;
            PG8_LDA(At, 1, 1); PG8_STAGE(PG8_SB(1, 0), b3, voffB); PG8_STAGE(PG8_SB(1, 1), b3 + hstep, voffB); PG8_STAGE(PG8_SA(1, 0), a3, voffA);
            PG8_WAIT_V(8); PG8_WAIT_L(0); PG8_BAR; PG8_MMA(1, 0, At, B0); PG8_MMA(1, 1, At, B1); PG8_BAR; PG8_SCHED;
            } else {
            PG8_LDB(B0, 0, 0); PG8_SCHED; PG8_LDA(At, 0, 0); PG8_STAGE(PG8_SA(1, 1), a1 + hstep, voffA);
            PG8_WAIT_L(8); PG8_BAR; PG8_WAIT_L(0); PG8_MMA(0, 0, At, B0); PG8_BAR; PG8_SCHED;
            PG8_LDB(B1, 0, 1); PG8_STAGE(PG8_SB(0, 0), b2, voffB);
            PG8_BAR; PG8_WAIT_L(0); PG8_MMA(0, 1, At, B1); PG8_BAR;
            PG8_LDA(At, 0, 1); PG8_STAGE(PG8_SA(0, 0), a2, voffA);
            PG8_BAR; PG8_WAIT_L(0); PG8_MMA(1, 0, At, B0); PG8_BAR; PG8_SCHED;
            PG8_STAGE(PG8_SB(0, 1), b2 + hstep, voffB);
            PG8_WAIT_V(6); PG8_BAR; PG8_MMA(1, 1, At, B1); PG8_BAR;
            PG8_LDB(B0, 1, 0); PG8_SCHED; PG8_LDA(At, 1, 0); PG8_STAGE(PG8_SA(0, 1), a2 + hstep, voffA);
            PG8_WAIT_L(8); PG8_BAR; PG8_WAIT_L(0); PG8_MMA(0, 0, At, B0); PG8_BAR; PG8_SCHED;
            PG8_LDB(B1, 1, 1); PG8_STAGE(PG8_SB(1, 0), b3, voffB);
            PG8_BAR; PG8_WAIT_L(0); PG8_MMA(0, 1, At, B1); PG8_BAR;
            PG8_LDA(At, 1, 1); PG8_STAGE(PG8_SA(1, 0), a3, voffA);
            PG8_BAR; PG8_WAIT_L(0); PG8_MMA(1, 0, At, B0); PG8_BAR; PG8_SCHED;
            PG8_STAGE(PG8_SB(1, 1), b3 + hstep, voffB);
            PG8_WAIT_V(6); PG8_BAR; PG8_MMA(1, 1, At, B1); PG8_BAR;
            }
        }
        if constexpr (ALIGN_EPI) { if (wr == 0) PG8_BAR; }
        if constexpr (!Epi::AFTER_DRAIN) { E(acc, cur, wr, wc, fr, fq); S.done(cur); }
        if (!has_next) break;
#pragma unroll
        for (int a = 0; a < 2; ++a)
#pragma unroll
            for (int b = 0; b < 2; ++b)
#pragma unroll
                for (int m = 0; m < 4; ++m)
#pragma unroll
                    for (int n = 0; n < 2; ++n) acc[a][b][m][n] = (f32x4){0.f, 0.f, 0.f, 0.f};
        cur = nxt; cA = nA; cB = nB; ++ui;
        if constexpr (ALIGN_EPI) { if (wr == 1) PG8_BAR; }
    }
    PG8_WAIT_V(0);
    if constexpr (!ALIGN_EPI) { if (wr == 0) PG8_BAR; }
    PG8_BAR;
#undef PG8_SA
#undef PG8_SB
#undef PG8_STAGE
#undef PG8_LDA
#undef PG8_LDB
#undef PG8_MMA
#undef PG8_WAIT_V
#undef PG8_WAIT_L
#undef PG8_BAR
#undef PG8_SCHED
}
}

constexpr int NWAVES = 8;
constexpr int D = 2048, FF = 5632, NGU = 2 * FF, DEPTH = 4;
constexpr int DCONV = 1024, GH = 4, GDK = 128, GDV = 256, GRANK = 16;
constexpr int NIN = 6160, NINP = 6400;
constexpr int R_SAMPLE = 8192, R_META = 9216, T_REAL = 9280, TP = 9472;
constexpr int PC_B = 0, PC_C = 1024, PC_H = 2048, PC_Q = 3072, PC_K = 3584, PC_V = 4096, PC_GO = 5120, PC_FL = 6144;
constexpr float EPS = 1e-6f;
constexpr size_t O_YP = 0, O_YS = 16777216, O_GP = 18874368, O_CP = 20971520, O_GS = 21004288, O_CS = 88113152, O_END = 89161728;
constexpr size_t MiB = 1u << 20;
constexpr size_t WS_CTL = 0, CTL_ZERO_BYTES = 32768;
constexpr size_t WS_W = 2 * MiB, W_LAYER = 165 * MiB;
constexpr size_t WO_GU1 = 0, WO_DN1 = 44 * MiB, WO_IN = 66 * MiB, WO_OUT = 91 * MiB, WO_GU2 = 99 * MiB, WO_DN2 = 143 * MiB;
constexpr size_t WS_H = 664 * MiB, WS_XN = 738 * MiB, WS_ACT = 776 * MiB, WS_PROJ = 878 * MiB, WS_YMIX = 994 * MiB, WS_SLAB = 1032 * MiB, WS_GQS = 1096 * MiB, WS_GPL = 1105 * MiB, WS_GEBL = 1110 * MiB, WS_GU = 1111 * MiB, WS_GS = 1177 * MiB, WS_END = 1210 * MiB;
static_assert(WS_W + DEPTH * W_LAYER <= WS_H && WS_H + (size_t)TP * D * 4 <= WS_XN && WS_XN + (size_t)TP * D * 2 <= WS_ACT && WS_ACT + (size_t)TP * FF * 2 <= WS_PROJ &&
              WS_PROJ + (size_t)TP * NINP * 2 <= WS_YMIX && WS_YMIX + (size_t)TP * D * 2 <= WS_SLAB && WS_SLAB + (size_t)256 * 65536 * 4 <= WS_GQS && WS_GQS + (size_t)528 * 16384 <= WS_GPL && WS_GPL + (size_t)528 * 8192 <= WS_GEBL && WS_GEBL + (size_t)528 * 512 <= WS_GU && WS_GU + (size_t)528 * 131072 <= WS_GS && WS_GS + (size_t)528 * 65536 <= WS_END, "d_ws map");
constexpr int TSP = 4;
constexpr int CW_BAR = 4096;
static_assert((CW_BAR + 3456) * 4 <= (int)CTL_ZERO_BYTES, "the per-call memset covers the barrier words");
constexpr int LDS_BYTES = 147456, MISC_OFF = 143360;

#define GAS __attribute__((address_space(1)))
#define LAS __attribute__((address_space(3)))
typedef unsigned short bf16;
typedef unsigned v4u __attribute__((ext_vector_type(4)));
typedef unsigned v2u __attribute__((ext_vector_type(2)));
typedef float f32x4 __attribute__((ext_vector_type(4)));
typedef float f32x2 __attribute__((ext_vector_type(2)));
#define DI __device__ __forceinline__
#define LDS_WAIT() asm volatile("s_waitcnt lgkmcnt(0)" ::: "memory")
DI unsigned f2bf(float f) { unsigned u = __builtin_bit_cast(unsigned, f); return (u + 0x7fffu + ((u >> 16) & 1u)) >> 16; }
typedef __bf16 bf16x2_t __attribute__((ext_vector_type(2)));
DI unsigned pk2(float lo, float hi) { f32x2 v = {lo, hi}; bf16x2_t r = __builtin_convertvector(v, bf16x2_t); return __builtin_bit_cast(unsigned, r); }
DI float bflo(unsigned w) { return __uint_as_float(w << 16); }
DI float bfhi(unsigned w) { return __uint_as_float(w & 0xffff0000u); }

#define XB_TMO      128
#define XB_XCNT(j)  (256  + 64 * (j))
#define XB_XSUB(j)  (1280 + 64 * (j))
#define XB_XGEN(j)  (2304 + 64 * (j))
#define XB_TOP      3328
#define XB_TOPGEN   3392
#define XCD_BAR_WORDS 3456
#define XB_SPIN_CAP (1u << 22)
__device__ __forceinline__ unsigned xb_ld(unsigned* p)              { return __hip_atomic_load(p, __ATOMIC_RELAXED, __HIP_MEMORY_SCOPE_AGENT); }
__device__ __forceinline__ unsigned xb_add(unsigned* p, unsigned v) { return __hip_atomic_fetch_add(p, v, __ATOMIC_RELAXED, __HIP_MEMORY_SCOPE_AGENT); }
__device__ __forceinline__ unsigned xb_xcc_id() { return (unsigned)__builtin_amdgcn_s_getreg((3 << 11) | 20) & 0xFu; }
#define XB_SPIN(cond, bar) do { unsigned _sp = 0; while (cond) { __builtin_amdgcn_s_sleep(1); \
    if ((++_sp & 255u) == 0u) { if (xb_ld(&(bar)[XB_TMO])) break; if (_sp > XB_SPIN_CAP) { atomicAdd(&(bar)[XB_TMO], 1u); break; } } } } while (0)
struct XcdBarrier { unsigned* bar; unsigned x; volatile LAS unsigned* st; };
__device__ __forceinline__ bool xb_t0(int wave_id) { return wave_id == 0 && fresh_lane() == 0; }
__device__ __forceinline__ XcdBarrier xcd_barrier_post(unsigned* bar, volatile LAS unsigned* st, int wave_id) {
    XcdBarrier b; b.bar = bar; b.x = xb_xcc_id(); b.st = st;
    if (xb_t0(wave_id)) (void)xb_add(&bar[XB_XCNT(b.x)], 1u);
    return b;
}
__device__ __forceinline__ void xcd_barrier_complete(unsigned* bar, unsigned x, unsigned& nloc, unsigned& nx) {
    const unsigned G = gridDim.x * gridDim.y * gridDim.z;
    unsigned sum, cnt, mine, sp = 0u;
    for (;;) {
        sum = 0u; cnt = 0u; mine = 0u;
#pragma unroll
        for (unsigned j = 0; j < 16; ++j) { const unsigned c = xb_ld(&bar[XB_XCNT(j)]); sum += c; cnt += (c > 0u) ? 1u : 0u; mine = (j == x) ? c : mine; }
        if (sum == G) break;
        __builtin_amdgcn_s_sleep(1);
        if ((++sp & 255u) == 0u) { if (xb_ld(&bar[XB_TMO])) break; if (sp > XB_SPIN_CAP) { atomicAdd(&bar[XB_TMO], 1u); break; } }
    }
    nloc = mine > 0u ? mine : 1u; nx = cnt > 0u ? cnt : 1u;
}
__device__ __forceinline__ void xcd_barrier(const XcdBarrier& b, int wave_id) {
    asm volatile("s_waitcnt vmcnt(0)" ::: "memory");
    __syncthreads();
    if (xb_t0(wave_id)) {
        unsigned* bar = b.bar;
        __builtin_amdgcn_s_waitcnt(0);
        unsigned nloc = b.st[0], nx = b.st[1];
        if (nloc == 0u) { xcd_barrier_complete(bar, b.x, nloc, nx); b.st[0] = nloc; b.st[1] = nx; }
        const unsigned old = xb_add(&bar[XB_XSUB(b.x)], 1u);
        const unsigned gen = old / nloc;
        if (old + 1u == (gen + 1u) * nloc) {
            __builtin_amdgcn_fence(__ATOMIC_RELEASE, "agent");
            asm volatile("s_waitcnt vmcnt(0)" ::: "memory");
            const unsigned og = xb_add(&bar[XB_TOP], 1u);
            const unsigned tg = og / nx;
            if (og + 1u == (tg + 1u) * nx) xb_add(&bar[XB_TOPGEN], 1u);
            else XB_SPIN(xb_ld(&bar[XB_TOPGEN]) == tg, bar);
            __builtin_amdgcn_fence(__ATOMIC_ACQUIRE, "agent");
            xb_add(&bar[XB_XGEN(b.x)], 1u);
            asm volatile("s_waitcnt vmcnt(0)" ::: "memory");
        } else {
            XB_SPIN(xb_ld(&bar[XB_XGEN(b.x)]) == gen, bar);
            __builtin_amdgcn_fence(__ATOMIC_ACQUIRE, "agent");
            asm volatile("s_waitcnt vmcnt(0)" ::: "memory");
        }
    }
    __syncthreads();
}

DI float wave_sum(float v) {
#pragma unroll
    for (int o = 1; o < 64; o <<= 1) v += __shfl_xor(v, o);
    return v;
}
DI int row_prompt(int b, int pos) { return pos < 16 ? R_META + b * 16 + pos : b * 2048 + pos - 16; }

DI int dst_row(int kind, int n) { if (kind == 0) return n; const int a = n < FF ? n : n - FF; return 256 * (a >> 7) + (n < FF ? 0 : 128) + (a & 127); }
struct CvItem { const float* W; bf16* WT; int K, N, kind, kb, nb; const float* G; };
DI void cv_load(const CvItem& it, int lane, f32x4 (&v)[16], f32x4 (&g)[2]) {
    const int k0 = 64 * it.kb, n0 = 64 * it.nb, lr = lane >> 4, lc = 4 * (lane & 15);
    const bool inb = (n0 + lc) < it.N;
#pragma unroll
    for (int i = 0; i < 16; ++i) v[i] = inb ? __builtin_nontemporal_load((const f32x4*)(it.W + (size_t)(k0 + 4 * i + lr) * it.N + n0 + lc)) : (f32x4){0.f, 0.f, 0.f, 0.f};
    if (it.G) { g[0] = *(const f32x4*)(it.G + k0 + 8 * (lane & 7)); g[1] = *(const f32x4*)(it.G + k0 + 8 * (lane & 7) + 4); } else { g[0] = (f32x4){1.f, 1.f, 1.f, 1.f}; g[1] = g[0]; }
}
DI void cv_finish(const CvItem& it, const f32x4 (&v)[16], const f32x4 (&g)[2], LAS float* scr, int lane) {
    const int k0 = 64 * it.kb, n0 = 64 * it.nb, lr = lane >> 4, lc = 4 * (lane & 15);
#pragma unroll
    for (int i = 0; i < 16; ++i) { LAS float* s = scr + (4 * i + lr) * 65 + lc; s[0] = v[i][0]; s[1] = v[i][1]; s[2] = v[i][2]; s[3] = v[i][3]; }
    LDS_WAIT(); asm volatile("" ::: "memory");
    const int c = lane & 7;
#pragma unroll
    for (int j = 0; j < 8; ++j) { const int nl = (lane >> 3) + 8 * j, n = n0 + nl; const LAS float* s = scr + (8 * c) * 65 + nl;
        v4u o; o.x = pk2(s[0 * 65] * g[0][0], s[1 * 65] * g[0][1]); o.y = pk2(s[2 * 65] * g[0][2], s[3 * 65] * g[0][3]); o.z = pk2(s[4 * 65] * g[1][0], s[5 * 65] * g[1][1]); o.w = pk2(s[6 * 65] * g[1][2], s[7 * 65] * g[1][3]);
        if (n < it.N) *(v4u*)(it.WT + (size_t)dst_row(it.kind, n) * it.K + k0 + 8 * c) = o; }
    LDS_WAIT(); asm volatile("" ::: "memory");
}
constexpr int I_GU = 32 * 176, I_DN = 88 * 32, I_IN = 32 * 97, I_OUT = 32 * 32, I_LAYER = 2 * I_GU + 2 * I_DN + I_IN + I_OUT;
DI CvItem cv_decode(const float* g1, const float* d1, const float* wi, const float* wo, const float* g2, const float* d2, const float* n1, const float* nm, const float* n2, unsigned char* wbase, int g) {
    const int l = g / I_LAYER; int r = g - l * I_LAYER; unsigned char* wl = wbase + (size_t)l * W_LAYER;
    if (r < I_GU) return CvItem{g1 + (size_t)l * D * NGU, (bf16*)(wl + WO_GU1), D, NGU, 1, r / 176, r % 176, n1 + (size_t)l * D}; r -= I_GU;
    if (r < I_DN) return CvItem{d1 + (size_t)l * FF * D, (bf16*)(wl + WO_DN1), FF, D, 0, r / 32, r % 32, nullptr}; r -= I_DN;
    if (r < I_IN) return CvItem{wi + (size_t)l * D * NIN, (bf16*)(wl + WO_IN), D, NIN, 0, r / 97, r % 97, nm + (size_t)l * D}; r -= I_IN;
    if (r < I_OUT) return CvItem{wo + (size_t)l * D * D, (bf16*)(wl + WO_OUT), D, D, 0, r / 32, r % 32, nullptr}; r -= I_OUT;
    if (r < I_GU) return CvItem{g2 + (size_t)l * D * NGU, (bf16*)(wl + WO_GU2), D, NGU, 1, r / 176, r % 176, n2 + (size_t)l * D}; r -= I_GU;
    return CvItem{d2 + (size_t)l * FF * D, (bf16*)(wl + WO_DN2), FF, D, 0, r / 32, r % 32, nullptr};
}
DI void convert_range(const float* g1, const float* d1, const float* wi, const float* wo, const float* g2, const float* d2, const float* n1, const float* nm, const float* n2, unsigned char* wl, int ib, int ie, int widx, int wstride, LAS float* scr, int lane) {
    int it = ib + widx; if (it >= ie) return;
    CvItem cur = cv_decode(g1, d1, wi, wo, g2, d2, n1, nm, n2, wl, it), nx = cur; f32x4 va[16], vb[16], ga[2], gb[2];
    cv_load(cur, lane, va, ga);
    for (;;) {
        bool has = it + wstride < ie;
        if (has) { nx = cv_decode(g1, d1, wi, wo, g2, d2, n1, nm, n2, wl, it + wstride); cv_load(nx, lane, vb, gb); }
        cv_finish(cur, va, ga, scr, lane);
        if (!has) break;
        it += wstride; cur = nx;
        has = it + wstride < ie;
        if (has) { nx = cv_decode(g1, d1, wi, wo, g2, d2, n1, nm, n2, wl, it + wstride); cv_load(nx, lane, va, ga); }
        cv_finish(cur, vb, gb, scr, lane);
        if (!has) break;
        it += wstride; cur = nx;
    }
}

template <int MODE>
DI bool norm_load(int row, const GAS float* xp, const GAS float* xs, const GAS float* meta, GAS bf16* h, GAS float* rs, const GAS float* slabs, float scale, LAS int* tmap, int lane, f32x4 (&v)[8]) {
    if (row >= TP) return false;
    if (row >= T_REAL) {
        if (MODE != 2) {
#pragma unroll
            for (int j = 0; j < 8; ++j) { if (MODE == 1) ((GAS v2u*)(h + (size_t)row * D))[lane + 64 * j] = (v2u){0u, 0u}; }
            if (lane < 2) ((GAS f32x4*)rs)[2 * row + lane] = (f32x4){lane == 0 ? __builtin_inff() : 0.f, 0.f, 0.f, 0.f};
        }
        return false;
    }
    if (MODE == 2 && row >= R_META) return false;
    if (MODE == 1) {
        const GAS float* src = row < R_SAMPLE ? xp + (size_t)row * D : (row < R_META ? xs + (size_t)(row - R_SAMPLE) * D : meta + (size_t)((row - R_META) & 15) * D);
#pragma unroll
        for (int j = 0; j < 8; ++j) v[j] = ((const GAS f32x4*)src)[lane + 64 * j];
    } else {
        v2u w[8];
#pragma unroll
        for (int j = 0; j < 8; ++j) w[j] = ((const GAS v2u*)(h + (size_t)row * D))[lane + 64 * j];
#pragma unroll
        for (int j = 0; j < 8; ++j) v[j] = (f32x4){bflo(w[j].x), bfhi(w[j].x), bflo(w[j].y), bfhi(w[j].y)};
    }
    if (MODE != 1) {
#pragma unroll
        for (int j = 0; j < 8; ++j) {
            const int tu = __builtin_amdgcn_readfirstlane(tmap[(row >> 8) * 8 + j]);
            if (tu >= 0) { const GAS bf16* sp = (const GAS bf16*)slabs + (size_t)tu * TSP * 65536 + (size_t)(row & 255) * 256 + 4 * lane; f32x4 a = (f32x4){0.f, 0.f, 0.f, 0.f};
#pragma unroll
                for (int ks = 0; ks < TSP; ++ks) { const v2u w2 = *(const GAS v2u*)(sp + (size_t)ks * 65536); a += (f32x4){bflo(w2.x), bfhi(w2.x), bflo(w2.y), bfhi(w2.y)}; }
                v[j] += a * scale;
                if (MODE == 0) ((GAS v2u*)(h + (size_t)row * D))[lane + 64 * j] = (v2u){pk2(v[j][0], v[j][1]), pk2(v[j][2], v[j][3])}; }
        }
    }
    return true;
}
template <int MODE>
DI void norm_finish(int row, const f32x4 (&v)[8], GAS bf16* h, const GAS float* gain, GAS float* rs, GAS float* out, int lane) {
    float ss = 0.f;
#pragma unroll
    for (int j = 0; j < 8; ++j) ss += (v[j][0] * v[j][0] + v[j][1] * v[j][1]) + (v[j][2] * v[j][2] + v[j][3] * v[j][3]);
    const float sst = wave_sum(ss); const float rstd = 1.0f / sqrtf(sst * (1.0f / D) + EPS);
    if (MODE == 2) {
        GAS float* o = out + (row < R_SAMPLE ? O_YP + (size_t)row * D : O_YS + (size_t)(row - R_SAMPLE) * D);
#pragma unroll
        for (int j = 0; j < 8; ++j) __builtin_nontemporal_store(v[j] * rstd * ((const GAS f32x4*)gain)[lane + 64 * j], (GAS f32x4*)o + lane + 64 * j);
    } else {
        if (lane < 2) ((GAS f32x4*)rs)[2 * row + lane] = (f32x4){lane == 0 ? sst : 0.f, 0.f, 0.f, 0.f};
        if (MODE == 1) {
#pragma unroll
            for (int j = 0; j < 8; ++j) ((GAS v2u*)(h + (size_t)row * D))[lane + 64 * j] = (v2u){pk2(v[j][0], v[j][1]), pk2(v[j][2], v[j][3])};
        }
    }
}
template <int MODE>
DI void norm_phase(const float* xp_, const float* xs_, const float* meta_, bf16* h_, const float* __restrict__ gain_, float* rs_, float* out_, int gw, int NGW, int lane,
                   const float* slabs_, float scale, int Kprev, int G, LAS unsigned char* lds, int tid) {
    int row_lo = 0;
    const GAS float* xp = (const GAS float*)xp_; const GAS float* xs = (const GAS float*)xs_; const GAS float* meta = (const GAS float*)meta_; GAS bf16* h = (GAS bf16*)h_;
    const GAS float* gain = (const GAS float*)gain_; GAS float* rs = (GAS float*)rs_; GAS float* out = (GAS float*)out_; const GAS float* slabs = (const GAS float*)slabs_;
    LAS int* tmap = (LAS int*)lds;
    if (MODE != 1) {
        for (int i = tid; i < (TP / 256) * 8; i += NWAVES * 64) tmap[i] = -1;
        __syncthreads();
        pg8::PanelTailOrder<TSP> S; S.init(TP, D, Kprev, G, 0);
        const int nt = S.ntail();
        if (tid < nt) { pg8::Unit u; if (S.tail_unit(tid, u)) tmap[u.pm * 8 + u.pn] = tid; }
        if (MODE == 0) row_lo = S.fast() ? 32 * 256 : TP;
        __syncthreads();
    }
    for (int row = row_lo + gw; row < TP; row += NGW) {
        f32x4 va[8];
        if (norm_load<MODE>(row, xp, xs, meta, h, rs, slabs, scale, tmap, lane, va)) norm_finish<MODE>(row, va, h, gain, rs, out, lane);
    }
}

DI void cvt16(const v4u a, const v4u b, float (&f)[16]) {
    f[0] = bflo(a.x); f[1] = bfhi(a.x); f[2] = bflo(a.y); f[3] = bfhi(a.y); f[4] = bflo(a.z); f[5] = bfhi(a.z); f[6] = bflo(a.w); f[7] = bfhi(a.w);
    f[8] = bflo(b.x); f[9] = bfhi(b.x); f[10] = bflo(b.y); f[11] = bfhi(b.y); f[12] = bflo(b.z); f[13] = bfhi(b.z); f[14] = bflo(b.w); f[15] = bfhi(b.w); }
DI void conv_phase(const bf16* proj_, bf16* ymix_, const float* __restrict__ cw_, const float* __restrict__ cg_, const float* __restrict__ sconv_  , float* out_, int l, int gw, int NGW, int lane) {
    const GAS bf16* proj = (const GAS bf16*)proj_; GAS bf16* ymix = (GAS bf16*)ymix_; const GAS float* cw = (const GAS float*)cw_; const GAS float* cg = (const GAS float*)cg_;
    const GAS float* sconv = (const GAS float*)sconv_; GAS float* out = (GAS float*)out_;
    const int c0 = 16 * lane;
    constexpr int NRUN = 4 * 516 + 128 * 2;
    for (int ri = gw; ri < NRUN; ri += NGW) {
        const bool isp = ri < 4 * 516; const int sq = isp ? ri / 516 : (ri - 4 * 516) >> 1, p0 = isp ? 4 * (ri - sq * 516) : 4 * ((ri - 4 * 516) & 1);
#define CONV_ROW(pos) (isp ? row_prompt(sq, (pos)) : R_SAMPLE + sq * 8 + (pos))
        float u1[16], u2[16], t[16];
        if (p0 > 0) { v4u hc[2][2], hh[2][2];
#pragma unroll
            for (int k = 0; k < 2; ++k) { const GAS bf16* pr = proj + (size_t)CONV_ROW(p0 - 2 + k) * NINP + c0;
                hc[k][0] = *(const GAS v4u*)(pr + PC_C); hc[k][1] = *(const GAS v4u*)(pr + PC_C + 8); hh[k][0] = *(const GAS v4u*)(pr + PC_H); hh[k][1] = *(const GAS v4u*)(pr + PC_H + 8); }
            cvt16(hc[0][0], hc[0][1], u2); cvt16(hh[0][0], hh[0][1], t);
#pragma unroll
            for (int i = 0; i < 16; ++i) u2[i] *= t[i];
            cvt16(hc[1][0], hc[1][1], u1); cvt16(hh[1][0], hh[1][1], t);
#pragma unroll
            for (int i = 0; i < 16; ++i) u1[i] *= t[i];
        } else if (!isp) {
#pragma unroll
            for (int i = 0; i < 4; ++i) { const f32x4 s0 = *(const GAS f32x4*)(sconv + ((size_t)sq * 2 + 0) * DCONV + c0 + 4 * i), s1 = *(const GAS f32x4*)(sconv + ((size_t)sq * 2 + 1) * DCONV + c0 + 4 * i);
#pragma unroll
                for (int e = 0; e < 4; ++e) { u2[4 * i + e] = s0[e]; u1[4 * i + e] = s1[e]; } }
        } else {
#pragma unroll
            for (int i = 0; i < 16; ++i) { u2[i] = 0.f; u1[i] = 0.f; }
        }
        v4u nb[2], nc[2], nh[2];
        { const GAS bf16* pr = proj + (size_t)CONV_ROW(p0) * NINP + c0;
          nb[0] = *(const GAS v4u*)(pr + PC_B); nb[1] = *(const GAS v4u*)(pr + PC_B + 8); nc[0] = *(const GAS v4u*)(pr + PC_C); nc[1] = *(const GAS v4u*)(pr + PC_C + 8); nh[0] = *(const GAS v4u*)(pr + PC_H); nh[1] = *(const GAS v4u*)(pr + PC_H + 8); }
#pragma unroll
        for (int k = 0; k < 4; ++k) {
            const int pos = p0 + k, row = CONV_ROW(pos);
            float cb[16], u0[16], y[16], w[16];
            cvt16(nb[0], nb[1], cb); cvt16(nc[0], nc[1], u0); cvt16(nh[0], nh[1], t);
            if (k < 3) { const GAS bf16* pr = proj + (size_t)CONV_ROW(pos + 1) * NINP + c0;
                nb[0] = *(const GAS v4u*)(pr + PC_B); nb[1] = *(const GAS v4u*)(pr + PC_B + 8); nc[0] = *(const GAS v4u*)(pr + PC_C); nc[1] = *(const GAS v4u*)(pr + PC_C + 8); nh[0] = *(const GAS v4u*)(pr + PC_H); nh[1] = *(const GAS v4u*)(pr + PC_H + 8); }
#pragma unroll
            for (int i = 0; i < 16; ++i) u0[i] *= t[i];
            float ss = 0.f;
#pragma unroll
            for (int i = 0; i < 4; ++i) { const f32x4 w0 = *(const GAS f32x4*)(cw + c0 + 4 * i), w1 = *(const GAS f32x4*)(cw + DCONV + c0 + 4 * i), w2 = *(const GAS f32x4*)(cw + 2 * DCONV + c0 + 4 * i);
#pragma unroll
                for (int e = 0; e < 4; ++e) { const int j = 4 * i + e; y[j] = cb[j] * (w0[e] * u2[j] + w1[e] * u1[j] + w2[e] * u0[j]); ss += y[j] * y[j]; } }
            ss += __shfl_xor(ss, 1); ss += __shfl_xor(ss, 2); ss += __shfl_xor(ss, 4);
            const float rs = 1.0f / sqrtf(ss * (1.0f / 128.0f) + EPS);
#pragma unroll
            for (int i = 0; i < 4; ++i) { const f32x4 g4 = *(const GAS f32x4*)(cg + c0 + 4 * i); w[4 * i] = g4[0]; w[4 * i + 1] = g4[1]; w[4 * i + 2] = g4[2]; w[4 * i + 3] = g4[3]; }
            v4u o0, o1;
            o0.x = pk2(y[0] * rs * w[0], y[1] * rs * w[1]); o0.y = pk2(y[2] * rs * w[2], y[3] * rs * w[3]); o0.z = pk2(y[4] * rs * w[4], y[5] * rs * w[5]); o0.w = pk2(y[6] * rs * w[6], y[7] * rs * w[7]);
            o1.x = pk2(y[8] * rs * w[8], y[9] * rs * w[9]); o1.y = pk2(y[10] * rs * w[10], y[11] * rs * w[11]); o1.z = pk2(y[12] * rs * w[12], y[13] * rs * w[13]); o1.w = pk2(y[14] * rs * w[14], y[15] * rs * w[15]);
            GAS bf16* yo = ymix + (size_t)row * D + c0; ((GAS v4u*)yo)[0] = o0; ((GAS v4u*)yo)[1] = o1;
            GAS float* uo = nullptr;
            if (isp) { if (pos >= 2062) uo = out + O_CP + ((size_t)(l * 4 + sq) * 2 + (pos - 2062)) * DCONV; }
            else if (pos >= 6) uo = out + O_CS + ((size_t)(l * 128 + sq) * 2 + (pos - 6)) * DCONV;
            if (uo) {
#pragma unroll
                for (int i = 0; i < 4; ++i) ((GAS f32x4*)(uo + c0))[i] = (f32x4){u0[4 * i], u0[4 * i + 1], u0[4 * i + 2], u0[4 * i + 3]}; }
#pragma unroll
            for (int i = 0; i < 16; ++i) { u2[i] = u1[i]; u1[i] = u0[i]; }
        }
#undef CONV_ROW
    }
}

typedef short bf16x8 __attribute__((ext_vector_type(8)));
DI unsigned pkbf(float lo, float hi) { f32x2 v = {lo, hi}; bf16x2_t r = __builtin_convertvector(v, bf16x2_t); return __builtin_bit_cast(unsigned, r); }
DI bf16x8 mk8(v2u lo, v2u hi) { v4u t = {lo.x, lo.y, hi.x, hi.y}; return __builtin_bit_cast(bf16x8, t); }
DI void tr2(unsigned a0, unsigned a1, v2u& r0, v2u& r1) {
    asm volatile("ds_read_b64_tr_b16 %0, %2\n\tds_read_b64_tr_b16 %1, %3\n\ts_waitcnt lgkmcnt(0)" : "=&v"(r0), "=&v"(r1) : "v"(a0), "v"(a1) : "memory");
}
#define LBAR() do { asm volatile("s_waitcnt lgkmcnt(0)" ::: "memory"); __builtin_amdgcn_s_barrier(); asm volatile("" ::: "memory"); } while (0)
constexpr int GS_QK = 272, GS_V = 528, GS_P = 144, GS_O = 1040;
constexpr int GL_QS = 0, GL_KD = 17408, GL_KL = 34816, GL_V = 52224, GL_PL = 86016, GL_FL = 95232, GL_GT = 99328, GL_EBL = 103424, GL_OL = 0;
DI int chunk_row(bool is_prompt, int bidx, int c, int t) {
    if (is_prompt) { if (c == 0) return t >= 48 ? R_META + 16 * bidx + (t - 48) : -1; return 2048 * bidx + 64 * (c - 1) + t; }
    return t >= 56 ? R_SAMPLE + 8 * bidx + (t - 56) : -1;
}
DI float logsig16(float x) { return (fminf(x, 0.f) - __logf(1.0f + __expf(-fabsf(x)))) * (1.0f / 16.0f); }

#define GLA_LANES() int tid = w * 64 + fresh_lane(); asm volatile("" : "+v"(tid)); const int lane = tid & 63, r = lane & 15, q = lane >> 4, dp = lane, c8 = tid & 31; (void)r; (void)q; (void)dp; (void)c8;
DI void gla_out_stage(LAS unsigned char* lds, const GAS bf16* proj, GAS bf16* ymix, const GAS float* __restrict__ gg, int hd, bool is_prompt, int bidx, int c, const int w) {
    GLA_LANES();
    const f32x4 ggA = *(const GAS f32x4*)(gg + 8 * c8), ggB = *(const GAS f32x4*)(gg + 8 * c8 + 4);
    v4u gw4[4]; int rows[4];
#pragma unroll
    for (int ps = 0; ps < 4; ++ps) { rows[ps] = chunk_row(is_prompt, bidx, c, 16 * ps + (tid >> 5)); const int rc = rows[ps] < 0 ? 0 : rows[ps];
        gw4[ps] = *(const GAS v4u*)(proj + (size_t)rc * NINP + PC_GO + 256 * hd + 8 * c8); }
#pragma unroll
    for (int ps = 0; ps < 4; ++ps) { const int t = 16 * ps + (tid >> 5); const LAS unsigned char* op = lds + GL_OL + t * GS_O + 32 * c8;
        const f32x4 oa = *(const LAS f32x4*)op, ob = *(const LAS f32x4*)(op + 16);
        float ss = (oa[0] * oa[0] + oa[1] * oa[1]) + (oa[2] * oa[2] + oa[3] * oa[3]) + (ob[0] * ob[0] + ob[1] * ob[1]) + (ob[2] * ob[2] + ob[3] * ob[3]);
        ss += __shfl_xor(ss, 1); ss += __shfl_xor(ss, 2); ss += __shfl_xor(ss, 4); ss += __shfl_xor(ss, 8); ss += __shfl_xor(ss, 16);
        const float rs = 1.0f / sqrtf(ss * (1.0f / 256.0f) + EPS);
        if (rows[ps] >= 0) { const v4u g4 = gw4[ps];
            const float gv[8] = {bflo(g4.x), bfhi(g4.x), bflo(g4.y), bfhi(g4.y), bflo(g4.z), bfhi(g4.z), bflo(g4.w), bfhi(g4.w)}; float y[8];
#pragma unroll
            for (int e = 0; e < 4; ++e) { y[e] = oa[e] * rs * ggA[e] * (gv[e] / (1.0f + __expf(-gv[e]))); y[4 + e] = ob[e] * rs * ggB[e] * (gv[4 + e] / (1.0f + __expf(-gv[4 + e]))); }
            *(GAS v4u*)(ymix + (size_t)rows[ps] * D + DCONV + 256 * hd + 8 * c8) = (v4u){pkbf(y[0], y[1]), pkbf(y[2], y[3]), pkbf(y[4], y[5]), pkbf(y[6], y[7])}; } }
}

DI void gla_sample_item(LAS unsigned char* lds, const GAS bf16* proj, GAS bf16* ymix, const GAS float* __restrict__ fw2, const GAS float* __restrict__ fb, const GAS float* __restrict__ gg,
                        int hd, int sb, const GAS float* S_in, GAS float* S_out, const int w) {
    const int lane = fresh_lane();
    LAS float* L_Q = (LAS float*)(lds + 0);
    LAS float* L_K = (LAS float*)(lds + 4096);
    LAS float* L_DEC = (LAS float*)(lds + 8192);
    LAS float* L_V = (LAS float*)(lds + 12288);
    LAS float* L_PART = (LAS float*)(lds + 20480);
    const int row = R_SAMPLE + sb * 8 + w;
    const GAS bf16* pr = proj + (size_t)row * NINP;
    f32x4 S[16];
#pragma unroll
    for (int i = 0; i < 16; ++i) S[i] = __builtin_nontemporal_load((const GAS f32x4*)(S_in + (size_t)(16 * w + i) * GDV) + lane);
    const v2u gw2 = *(const GAS v2u*)(pr + PC_GO + 256 * hd + 4 * lane);
    const f32x4 ggv = ((const GAS f32x4*)gg)[lane];
    {
        const v4u f0 = *(const GAS v4u*)(pr + PC_FL), f1 = *(const GAS v4u*)(pr + PC_FL + 8);
        const float fl[16] = {bflo(f0.x), bfhi(f0.x), bflo(f0.y), bfhi(f0.y), bflo(f0.z), bfhi(f0.z), bflo(f0.w), bfhi(f0.w), bflo(f1.x), bfhi(f1.x), bflo(f1.y), bfhi(f1.y), bflo(f1.z), bfhi(f1.z), bflo(f1.w), bfhi(f1.w)};
        const f32x2 fbv = *(const GAS f32x2*)(fb + 128 * hd + 2 * lane);
        float x0 = fbv[0], x1 = fbv[1];
#pragma unroll
        for (int r = 0; r < 16; ++r) { const f32x2 ww = *(const GAS f32x2*)(fw2 + r * 512 + 128 * hd + 2 * lane); x0 += fl[r] * ww[0]; x1 += fl[r] * ww[1]; }
        const unsigned qw = *(const GAS unsigned*)(pr + PC_Q + 128 * hd + 2 * lane), kw = *(const GAS unsigned*)(pr + PC_K + 128 * hd + 2 * lane);
        const float qs = 0.08838834764831845f;
        *(LAS f32x2*)(L_Q + w * 128 + 2 * lane) = (f32x2){bflo(qw) * qs, bfhi(qw) * qs};
        *(LAS f32x2*)(L_K + w * 128 + 2 * lane) = (f32x2){bflo(kw), bfhi(kw)};
        *(LAS f32x2*)(L_DEC + w * 128 + 2 * lane) = (f32x2){__expf(logsig16(x0)), __expf(logsig16(x1))};
        const v2u vw = *(const GAS v2u*)(pr + PC_V + 256 * hd + 4 * lane);
        *(LAS f32x4*)(L_V + w * 256 + 4 * lane) = (f32x4){bflo(vw.x), bfhi(vw.x), bflo(vw.y), bfhi(vw.y)};
    }
    LBAR();
#pragma unroll 2
    for (int t = 0; t < 8; ++t) {
        const f32x4 vv = *(const LAS f32x4*)(L_V + t * 256 + 4 * lane);
        f32x4 po = (f32x4){0.f, 0.f, 0.f, 0.f};
#pragma unroll
        for (int i4 = 0; i4 < 4; ++i4) {
            const f32x4 dq = *(const LAS f32x4*)(L_DEC + t * 128 + 16 * w + 4 * i4), kq = *(const LAS f32x4*)(L_K + t * 128 + 16 * w + 4 * i4), qq = *(const LAS f32x4*)(L_Q + t * 128 + 16 * w + 4 * i4);
#pragma unroll
            for (int e = 0; e < 4; ++e) { const int i = 4 * i4 + e; S[i] = S[i] * dq[e] + vv * kq[e]; po += S[i] * qq[e]; }
        }
        *(LAS f32x4*)(L_PART + (t * 8 + w) * 256 + 4 * lane) = po;
    }
#pragma unroll
    for (int i = 0; i < 16; ++i) __builtin_nontemporal_store(S[i], (GAS f32x4*)(S_out + (size_t)(16 * w + i) * GDV) + lane);
    LBAR();
    {
        f32x4 o = (f32x4){0.f, 0.f, 0.f, 0.f};
#pragma unroll
        for (int ww = 0; ww < 8; ++ww) o += *(const LAS f32x4*)(L_PART + (w * 8 + ww) * 256 + 4 * lane);
        const float ss = wave_sum((o[0] * o[0] + o[1] * o[1]) + (o[2] * o[2] + o[3] * o[3]));
        const float rs = 1.0f / sqrtf(ss * (1.0f / 256.0f) + EPS);
        const float gv[4] = {bflo(gw2.x), bfhi(gw2.x), bflo(gw2.y), bfhi(gw2.y)}; float y[4];
#pragma unroll
        for (int e = 0; e < 4; ++e) y[e] = o[e] * rs * ggv[e] * (gv[e] / (1.0f + __expf(-gv[e])));
        *(GAS v2u*)(ymix + (size_t)row * D + DCONV + 256 * hd + 4 * lane) = (v2u){pkbf(y[0], y[1]), pkbf(y[2], y[3])};
    }
    LBAR();
}

DI void gla_item_mfma(LAS unsigned char* lds, const GAS bf16* proj, GAS bf16* ymix, const GAS float* __restrict__ fw2, const GAS float* __restrict__ fb, const GAS float* __restrict__ gg,
                      int hd, bool is_prompt, int bidx, int c0, const GAS float* S_in, GAS float* S_out, const int w,
                      GAS bf16* gqs, GAS bf16* gpl, GAS float* gebl, GAS float* gu) {
    const int tg = w;
#define GLA_LOAD_QK(c, DP) do { \
        _Pragma("unroll") for (int i = 0; i < 8; ++i) { const int row_ = chunk_row(is_prompt, bidx, (c), 8 * tg + i); const int rc_ = row_ < 0 ? 0 : row_; \
            const GAS bf16* p_ = proj + (size_t)rc_ * NINP + 128 * hd + 2 * (DP); const unsigned qv_ = *(const GAS unsigned*)(p_ + PC_Q), kv_ = *(const GAS unsigned*)(p_ + PC_K); qw[i] = row_ < 0 ? 0u : qv_; kw[i] = row_ < 0 ? 0u : kv_; } \
    } while (0)
#define GLA_LOAD_V(c) do { \
        _Pragma("unroll") for (int i = 0; i < 4; ++i) { const int row_ = chunk_row(is_prompt, bidx, (c), (tid >> 5) + 16 * i); const int rc_ = row_ < 0 ? 0 : row_; \
            const v4u vv_ = *(const GAS v4u*)(proj + (size_t)rc_ * NINP + PC_V + 256 * hd + 8 * c8); vr[i] = row_ < 0 ? (v4u){0u, 0u, 0u, 0u} : vv_; } \
        { const int row_ = chunk_row(is_prompt, bidx, (c), (tid >> 1) & 63); const int rc_ = row_ < 0 ? 0 : row_; const v4u ff_ = *(const GAS v4u*)(proj + (size_t)rc_ * NINP + PC_FL + 8 * (tid & 1)); flr = row_ < 0 ? (v4u){0u, 0u, 0u, 0u} : ff_; } \
    } while (0)
    {
        const int c = c0;
        const int tmin = is_prompt ? (c == 0 ? 48 : 0) : 56;
        {
            GLA_LANES();
            v4u vr[4]; v4u flr;
            GLA_LOAD_V(c);
#pragma unroll
            for (int i = 0; i < 4; ++i) *(LAS v4u*)(lds + GL_V + ((tid >> 5) + 16 * i) * GS_V + 16 * c8) = vr[i];
            if (tid < 128) { LAS float* f = (LAS float*)(lds + GL_FL) + (tid >> 1) * 16 + 8 * (tid & 1);
                *(LAS f32x4*)f = (f32x4){bflo(flr.x), bfhi(flr.x), bflo(flr.y), bfhi(flr.y)}; *(LAS f32x4*)(f + 4) = (f32x4){bflo(flr.z), bfhi(flr.z), bflo(flr.w), bfhi(flr.w)}; }
        }
        LBAR();
        {
            const int dpa = fresh_lane();
            const f32x2 fbv = *(const GAS f32x2*)(fb + 128 * hd + 2 * dpa);
            unsigned qw[8], kw[8];
            GLA_LOAD_QK(c, dpa);
            float c0[8], c1[8]; float run0 = 0.f, run1 = 0.f;
#pragma unroll
            for (int i = 0; i < 8; ++i) { c0[i] = fbv[0]; c1[i] = fbv[1]; }
#pragma unroll
            for (int j = 0; j < 4; ++j) { f32x2 fwj[4];
#pragma unroll
                for (int e = 0; e < 4; ++e) fwj[e] = *(const GAS f32x2*)(fw2 + (4 * j + e) * 512 + 128 * hd + 2 * dpa);
#pragma unroll
                for (int i = 0; i < 8; ++i) { const f32x4 f = ((const LAS f32x4*)(lds + GL_FL))[(8 * tg + i) * 4 + j];
#pragma unroll
                    for (int e = 0; e < 4; ++e) { c0[i] += f[e] * fwj[e][0]; c1[i] += f[e] * fwj[e][1]; } }
                __builtin_amdgcn_sched_barrier(0); }
#pragma unroll
            for (int i = 0; i < 8; ++i) { const bool valid = (8 * tg + i) >= tmin;
                run0 += valid ? logsig16(c0[i]) : 0.f; run1 += valid ? logsig16(c1[i]) : 0.f; c0[i] = run0; c1[i] = run1; if (i & 1) __builtin_amdgcn_sched_barrier(0); }
            { const int dp2 = fresh_lane(); *(LAS f32x2*)(lds + GL_GT + (tg * 128 + 2 * dp2) * 4) = (f32x2){run0, run1}; }
            LBAR();
            const int dp = fresh_lane();
            float off0 = 0.f, off1 = 0.f, tot0 = 0.f, tot1 = 0.f;
#pragma unroll
            for (int g8 = 0; g8 < 8; ++g8) { const f32x2 v = *(const LAS f32x2*)(lds + GL_GT + (g8 * 128 + 2 * dp) * 4); tot0 += v[0]; tot1 += v[1]; if (g8 < tg) { off0 += v[0]; off1 += v[1]; } }
#pragma unroll
            for (int i = 0; i < 8; ++i) { const int t = 8 * tg + i; const float b0 = off0 + c0[i], b1 = off1 + c1[i];
                const float eb0 = __expf(b0), eb1 = __expf(b1), en0 = __expf(-b0), en1 = __expf(-b1), el0 = __expf(tot0 - b0), el1 = __expf(tot1 - b1);
                const float q0 = bflo(qw[i]) * 0.08838834764831845f, q1 = bfhi(qw[i]) * 0.08838834764831845f, k0 = bflo(kw[i]), k1 = bfhi(kw[i]);
                *(LAS unsigned*)(lds + GL_QS + t * GS_QK + 4 * dp) = pkbf(q0 * eb0, q1 * eb1);
                *(LAS unsigned*)(lds + GL_KD + t * GS_QK + 4 * dp) = pkbf(k0 * en0, k1 * en1);
                *(LAS unsigned*)(lds + GL_KL + t * GS_QK + 4 * dp) = pkbf(k0 * el0, k1 * el1); if (i & 1) __builtin_amdgcn_sched_barrier(0); }
            if (tg == 0) *(LAS f32x2*)(lds + GL_EBL + 8 * dp) = (f32x2){__expf(tot0), __expf(tot1)};
        }
        LBAR();
        {
            GLA_LANES();
#pragma unroll
            for (int j2 = 0; j2 < 2; ++j2) { const int idx = 2 * w + j2, st = idx >> 2, tt = idx & 3;
                f32x4 acc = (f32x4){0.f, 0.f, 0.f, 0.f};
                if (st <= tt) {
#pragma unroll
                    for (int ks = 0; ks < 4; ++ks) { const bf16x8 a = *(const LAS bf16x8*)(lds + GL_KD + (16 * st + r) * GS_QK + (32 * ks + 8 * q) * 2), b = *(const LAS bf16x8*)(lds + GL_QS + (16 * tt + r) * GS_QK + (32 * ks + 8 * q) * 2);
                        acc = __builtin_amdgcn_mfma_f32_16x16x32_bf16(a, b, acc, 0, 0, 0); }
                }
                const int tq = 16 * tt + r, s0 = 16 * st + 4 * q;
                const float p0 = (s0 + 0 <= tq) ? acc[0] : 0.f, p1 = (s0 + 1 <= tq) ? acc[1] : 0.f, p2 = (s0 + 2 <= tq) ? acc[2] : 0.f, p3 = (s0 + 3 <= tq) ? acc[3] : 0.f;
                *(LAS v2u*)(lds + GL_PL + tq * GS_P + s0 * 2) = (v2u){pkbf(p0, p1), pkbf(p2, p3)}; }
        }
        LBAR();
        if (is_prompt) {
            GLA_LANES();
            const unsigned lbase = (unsigned)(uintptr_t)lds;
            bf16x8 Vf[2][2];
#pragma unroll
            for (int ks = 0; ks < 2; ++ks)
#pragma unroll
                for (int vt = 0; vt < 2; ++vt) { const unsigned a0 = lbase + GL_V + (32 * ks + 8 * q + (r >> 2)) * GS_V + (32 * w + 16 * vt + 4 * (r & 3)) * 2; v2u lo, hi; tr2(a0, a0 + 4 * GS_V, lo, hi); Vf[ks][vt] = mk8(lo, hi); }
#pragma unroll
            for (int dt = 0; dt < 8; ++dt) { f32x4 C0 = (f32x4){0.f, 0.f, 0.f, 0.f}, C1 = (f32x4){0.f, 0.f, 0.f, 0.f};
#pragma unroll
                for (int ks = 0; ks < 2; ++ks) { const unsigned a0 = lbase + GL_KL + (32 * ks + 8 * q + (r >> 2)) * GS_QK + (16 * dt + 4 * (r & 3)) * 2; v2u lo, hi; tr2(a0, a0 + 4 * GS_QK, lo, hi); const bf16x8 kl = mk8(lo, hi);
                    C0 = __builtin_amdgcn_mfma_f32_16x16x32_bf16(Vf[ks][0], kl, C0, 0, 0, 0); C1 = __builtin_amdgcn_mfma_f32_16x16x32_bf16(Vf[ks][1], kl, C1, 0, 0, 0); }
                GAS bf16* up = (GAS bf16*)gu + (size_t)(16 * dt + r) * GDV + 32 * w + 4 * q; *(GAS v2u*)up = (v2u){pkbf(C0[0], C0[1]), pkbf(C0[2], C0[3])}; *(GAS v2u*)(up + 16) = (v2u){pkbf(C1[0], C1[1]), pkbf(C1[2], C1[3])}; __builtin_amdgcn_sched_barrier(0); }
            { const int row = tid >> 3, ch = tid & 7;
              const v4u a = *(const LAS v4u*)(lds + GL_QS + row * GS_QK + 32 * ch), b2 = *(const LAS v4u*)(lds + GL_QS + row * GS_QK + 32 * ch + 16);
              *(GAS v4u*)(gqs + row * 128 + 16 * ch) = a; *(GAS v4u*)(gqs + row * 128 + 16 * ch + 8) = b2;
              *(GAS v4u*)(gpl + row * 64 + 8 * ch) = *(const LAS v4u*)(lds + GL_PL + row * GS_P + 16 * ch);
              if (tid < 128) gebl[tid] = *(const LAS float*)(lds + GL_EBL + 4 * tid); }
            LBAR();
            return;
        }
        f32x4 O[4][2]; f32x4 Sacc[8][2];
        {
            GLA_LANES();
            { const GAS float* sp = S_in + (size_t)(4 * q) * GDV + 32 * w + r;
#pragma unroll
              for (int dt = 0; dt < 8; ++dt)
#pragma unroll
                  for (int vt = 0; vt < 2; ++vt)
#pragma unroll
                      for (int i = 0; i < 4; ++i) Sacc[dt][vt][i] = sp[(16 * dt + i) * GDV + 16 * vt]; }
            const unsigned lbase = (unsigned)(uintptr_t)lds;
#pragma unroll
            for (int tt = 0; tt < 4; ++tt) { O[tt][0] = (f32x4){0.f, 0.f, 0.f, 0.f}; O[tt][1] = (f32x4){0.f, 0.f, 0.f, 0.f}; }
#pragma unroll
            for (int ks = 0; ks < 4; ++ks) {
                bf16x8 Sb[2];
#pragma unroll
                for (int vt = 0; vt < 2; ++vt) { const f32x4 lo = Sacc[2 * ks][vt], hi = Sacc[2 * ks + 1][vt]; Sb[vt] = __builtin_bit_cast(bf16x8, (v4u){pkbf(lo[0], lo[1]), pkbf(lo[2], lo[3]), pkbf(hi[0], hi[1]), pkbf(hi[2], hi[3])}); }
#pragma unroll
                for (int tt = 0; tt < 4; ++tt) { const LAS unsigned char* qp = lds + GL_QS + (16 * tt + r) * GS_QK + (32 * ks + 4 * q) * 2;
                    const bf16x8 a = mk8(*(const LAS v2u*)qp, *(const LAS v2u*)(qp + 32));
                    O[tt][0] = __builtin_amdgcn_mfma_f32_16x16x32_bf16(a, Sb[0], O[tt][0], 0, 0, 0); O[tt][1] = __builtin_amdgcn_mfma_f32_16x16x32_bf16(a, Sb[1], O[tt][1], 0, 0, 0); }
                __builtin_amdgcn_sched_barrier(0);
            }
            bf16x8 Vf[2][2];
#pragma unroll
            for (int ks = 0; ks < 2; ++ks)
#pragma unroll
                for (int vt = 0; vt < 2; ++vt) { const unsigned a0 = lbase + GL_V + (32 * ks + 8 * q + (r >> 2)) * GS_V + (32 * w + 16 * vt + 4 * (r & 3)) * 2; v2u lo, hi; tr2(a0, a0 + 4 * GS_V, lo, hi); Vf[ks][vt] = mk8(lo, hi); }
#pragma unroll
            for (int ks = 0; ks < 2; ++ks)
#pragma unroll
                for (int tt = 0; tt < 4; ++tt) { const bf16x8 a = *(const LAS bf16x8*)(lds + GL_PL + (16 * tt + r) * GS_P + (32 * ks + 8 * q) * 2);
                    O[tt][0] = __builtin_amdgcn_mfma_f32_16x16x32_bf16(a, Vf[ks][0], O[tt][0], 0, 0, 0); O[tt][1] = __builtin_amdgcn_mfma_f32_16x16x32_bf16(a, Vf[ks][1], O[tt][1], 0, 0, 0); }
            __builtin_amdgcn_sched_barrier(0);
#pragma unroll
            for (int dt = 0; dt < 8; ++dt) { const f32x4 e4 = *(const LAS f32x4*)(lds + GL_EBL + (16 * dt + 4 * q) * 4);
                f32x4 C0 = Sacc[dt][0] * e4, C1 = Sacc[dt][1] * e4;
#pragma unroll
                for (int ks = 0; ks < 2; ++ks) { const unsigned a0 = lbase + GL_KL + (32 * ks + 8 * q + (r >> 2)) * GS_QK + (16 * dt + 4 * (r & 3)) * 2; v2u lo, hi; tr2(a0, a0 + 4 * GS_QK, lo, hi); const bf16x8 a = mk8(lo, hi);
                    C0 = __builtin_amdgcn_mfma_f32_16x16x32_bf16(a, Vf[ks][0], C0, 0, 0, 0); C1 = __builtin_amdgcn_mfma_f32_16x16x32_bf16(a, Vf[ks][1], C1, 0, 0, 0); }
                GAS float* so = S_out + (size_t)(16 * dt + 4 * q) * GDV + 32 * w + r;
#pragma unroll
                for (int i = 0; i < 4; ++i) { so[i * GDV] = C0[i]; so[i * GDV + 16] = C1[i]; }
                __builtin_amdgcn_sched_barrier(0); }
        }
        LBAR();
        {   GLA_LANES();
#pragma unroll
            for (int tt = 0; tt < 4; ++tt)
#pragma unroll
                for (int vt = 0; vt < 2; ++vt)
#pragma unroll
                    for (int i = 0; i < 4; ++i) *(LAS float*)(lds + GL_OL + (16 * tt + 4 * q + i) * GS_O + (32 * w + 16 * vt + r) * 4) = O[tt][vt][i];
        }
        LBAR();
        gla_out_stage(lds, proj, ymix, gg, hd, is_prompt, bidx, c, w);
        LBAR();
    }
#undef GLA_LOAD_QK
#undef GLA_LOAD_V
}

DI void gla_scan_phase(const GAS float* gu, const GAS float* gebl, GAS bf16* gs, GAS float* out_state, int gtid, int nthreads) {
    for (int e = gtid; e < 16 * 8192; e += nthreads) {
        const int bh = e >> 13, rem = e & 8191, d = rem >> 6, v = (rem & 63) * 4;
        f32x4 S = (f32x4){0.f, 0.f, 0.f, 0.f};
#pragma nounroll
        for (int c3 = 0; c3 < 33; c3 += 11) {
            f32x4 u[11]; float eb[11];
#pragma unroll
            for (int j = 0; j < 11; ++j) { const size_t idx = (size_t)bh * 33 + c3 + j; const v2u w2 = *(const GAS v2u*)((const GAS bf16*)gu + (idx * GDK + d) * GDV + v); u[j] = (f32x4){bflo(w2.x), bfhi(w2.x), bflo(w2.y), bfhi(w2.y)}; eb[j] = gebl[idx * GDK + d]; }
#pragma unroll
            for (int j = 0; j < 11; ++j) { const size_t idx = (size_t)bh * 33 + c3 + j;
                *(GAS v2u*)(gs + (idx * GDK + d) * GDV + v) = (v2u){pkbf(S[0], S[1]), pkbf(S[2], S[3])};
                S = S * eb[j] + u[j]; }
        }
        *(GAS f32x4*)(out_state + ((size_t)bh * GDK + d) * GDV + v) = S;
    }
}

constexpr int CS_S = 0, CS_QS = 67584, CS_PL = 84992, CS_V = 94208;
DI void gla_passC_item(LAS unsigned char* lds, const GAS bf16* proj, GAS bf16* ymix, const GAS float* __restrict__ gg, int hd, int bidx, int c, const int w,
                       const GAS bf16* gqs, const GAS bf16* gpl, const GAS bf16* gs) {
    {   GLA_LANES();
        v4u sr[8], qr[2], pr, vr[4];
        if (c != 0) {
#pragma unroll
            for (int i = 0; i < 8; ++i) sr[i] = *(const GAS v4u*)(gs + (size_t)((tid >> 5) + 16 * i) * GDV + 8 * c8);
        }
        { const int row = tid >> 3, ch = tid & 7; qr[0] = *(const GAS v4u*)(gqs + row * 128 + 16 * ch); qr[1] = *(const GAS v4u*)(gqs + row * 128 + 16 * ch + 8); pr = *(const GAS v4u*)(gpl + row * 64 + 8 * ch); }
#pragma unroll
        for (int i = 0; i < 4; ++i) { const int row_ = chunk_row(true, bidx, c, (tid >> 5) + 16 * i); const int rc_ = row_ < 0 ? 0 : row_;
            const v4u vv_ = *(const GAS v4u*)(proj + (size_t)rc_ * NINP + PC_V + 256 * hd + 8 * c8); vr[i] = row_ < 0 ? (v4u){0u, 0u, 0u, 0u} : vv_; }
        if (c != 0) {
#pragma unroll
            for (int i = 0; i < 8; ++i) *(LAS v4u*)(lds + CS_S + ((tid >> 5) + 16 * i) * GS_V + 16 * c8) = sr[i];
        }
        { const int row = tid >> 3, ch = tid & 7; *(LAS v4u*)(lds + CS_QS + row * GS_QK + 32 * ch) = qr[0]; *(LAS v4u*)(lds + CS_QS + row * GS_QK + 32 * ch + 16) = qr[1]; *(LAS v4u*)(lds + CS_PL + row * GS_P + 16 * ch) = pr; }
#pragma unroll
        for (int i = 0; i < 4; ++i) *(LAS v4u*)(lds + CS_V + ((tid >> 5) + 16 * i) * GS_V + 16 * c8) = vr[i];
    }
    LBAR();
    f32x4 O[4][2];
    {   GLA_LANES();
        const unsigned lbase = (unsigned)(uintptr_t)lds;
#pragma unroll
        for (int tt = 0; tt < 4; ++tt) { O[tt][0] = (f32x4){0.f, 0.f, 0.f, 0.f}; O[tt][1] = (f32x4){0.f, 0.f, 0.f, 0.f}; }
        if (c != 0) {
#pragma unroll
        for (int ks = 0; ks < 4; ++ks) {
            bf16x8 Sf[2];
#pragma unroll
            for (int vt = 0; vt < 2; ++vt) { const unsigned a0 = lbase + CS_S + (32 * ks + 8 * q + (r >> 2)) * GS_V + (32 * w + 16 * vt + 4 * (r & 3)) * 2; v2u lo, hi; tr2(a0, a0 + 4 * GS_V, lo, hi); Sf[vt] = mk8(lo, hi); }
#pragma unroll
            for (int tt = 0; tt < 4; ++tt) { const bf16x8 a = *(const LAS bf16x8*)(lds + CS_QS + (16 * tt + r) * GS_QK + (32 * ks + 8 * q) * 2);
                O[tt][0] = __builtin_amdgcn_mfma_f32_16x16x32_bf16(a, Sf[0], O[tt][0], 0, 0, 0); O[tt][1] = __builtin_amdgcn_mfma_f32_16x16x32_bf16(a, Sf[1], O[tt][1], 0, 0, 0); }
            __builtin_amdgcn_sched_barrier(0);
        }
        }
#pragma unroll
        for (int ks = 0; ks < 2; ++ks) {
            bf16x8 Vf[2];
#pragma unroll
            for (int vt = 0; vt < 2; ++vt) { const unsigned a0 = lbase + CS_V + (32 * ks + 8 * q + (r >> 2)) * GS_V + (32 * w + 16 * vt + 4 * (r & 3)) * 2; v2u lo, hi; tr2(a0, a0 + 4 * GS_V, lo, hi); Vf[vt] = mk8(lo, hi); }
#pragma unroll
            for (int tt = 0; tt < 4; ++tt) { const bf16x8 a = *(const LAS bf16x8*)(lds + CS_PL + (16 * tt + r) * GS_P + (32 * ks + 8 * q) * 2);
                O[tt][0] = __builtin_amdgcn_mfma_f32_16x16x32_bf16(a, Vf[0], O[tt][0], 0, 0, 0); O[tt][1] = __builtin_amdgcn_mfma_f32_16x16x32_bf16(a, Vf[1], O[tt][1], 0, 0, 0); }
            __builtin_amdgcn_sched_barrier(0);
        }
    }
    LBAR();
    {   GLA_LANES();
#pragma unroll
        for (int tt = 0; tt < 4; ++tt)
#pragma unroll
            for (int vt = 0; vt < 2; ++vt)
#pragma unroll
                for (int i = 0; i < 4; ++i) *(LAS float*)(lds + GL_OL + (16 * tt + 4 * q + i) * GS_O + (32 * w + 16 * vt + r) * 4) = O[tt][vt][i];
    }
    LBAR();
    gla_out_stage(lds, proj, ymix, gg, hd, true, bidx, c, w);
    LBAR();
}
#undef GLA_LANES

struct Args { const float* in[20]; float* out; unsigned char* ws; int ph_lo, ph_hi; };
constexpr int N_PHASES = 1 + 12 * DEPTH;

__global__ void __launch_bounds__(NWAVES * 64, 2) mk_fwd(Args args) {
    extern __shared__ __attribute__((aligned(16))) unsigned char lds_raw[];
    LAS unsigned char* lds = (LAS unsigned char*)lds_raw;
    volatile LAS unsigned* MISC = (volatile LAS unsigned*)(lds + MISC_OFF);
    const int tid = threadIdx.x, lane = tid & 63, wave = __builtin_amdgcn_readfirstlane(tid >> 6);
    const int G = gridDim.x, bx = blockIdx.x;
    const int vcu = (G % 8 == 0) ? (bx % 8) * (G / 8) + bx / 8 : bx;
    const int gw = vcu * NWAVES + wave, NGW = G * NWAVES;
    unsigned char* ws = args.ws;
    unsigned* ctl = (unsigned*)(ws + WS_CTL);
    bf16* hbuf = (bf16*)(ws + WS_H); float* xn = (float*)(ws + WS_XN); bf16* act = (bf16*)(ws + WS_ACT); bf16* proj = (bf16*)(ws + WS_PROJ); bf16* ymix = (bf16*)(ws + WS_YMIX);
    if (tid < 32) MISC[tid] = 0u;
    __syncthreads();
    XcdBarrier bar; bar.bar = ctl + CW_BAR; bar.x = 0; bar.st = nullptr;
    if (MK_N_LAUNCHES == 1) bar = xcd_barrier_post(ctl + CW_BAR, MISC + 8, wave);
    const int lo = args.ph_lo, hi = args.ph_hi;
#define IN(k) (lo <= (k) && (k) < hi)
#define SEAM(k) do { if (MK_N_LAUNCHES == 1 && IN((k) + 1)) xcd_barrier(bar, wave); } while (0)

#define CONVERT_RANGE(ib, ie, widx, wstride) convert_range(args.in[6], args.in[7], args.in[9], args.in[15], args.in[17], args.in[18], args.in[5], args.in[8], args.in[16], args.ws + WS_W, (ib), (ie), (widx), (wstride), (LAS float*)(lds + wave * 16640), fresh_lane())
#define CONVERT_IN_TAIL(nbusy, ib, ie) do { int fi_ = (nbusy), ni_ = G_ - fi_; if (ni_ <= 0) { fi_ = 0; ni_ = G_; } \
        const int gb_ = I_GU + l_p * I_LAYER + (ib), ge_ = (I_GU + l_p * I_LAYER + (ie)) < DEPTH * I_LAYER ? (I_GU + l_p * I_LAYER + (ie)) : DEPTH * I_LAYER; \
        if (bx_ >= fi_ && gb_ < ge_) CONVERT_RANGE(gb_, ge_, (bx_ - fi_) * NWAVES + wave, ni_ * NWAVES); } while (0)
    constexpr int CV0 = 0, CV1 = 5914, CV2 = 8294, CV3 = 11864, CV4 = 12730, CV5 = 18644, CV6 = I_LAYER;
    static_assert(I_GU + CV1 >= I_GU + I_DN && I_GU + CV2 >= I_GU + I_DN + I_IN && I_GU + CV3 >= I_GU + I_DN + I_IN + I_OUT && I_GU + CV4 >= 2 * I_GU + I_DN + I_IN + I_OUT && I_GU + CV5 >= I_LAYER, "conversion runs ahead of consumption");
    if (IN(0)) {
        CONVERT_RANGE(0, I_GU, gw, NGW);
        for (int i = gw * 64 + lane; i < DEPTH * (NINP - NIN) * (D / 8); i += NGW * 64) { const int l = i / ((NINP - NIN) * (D / 8)), r = i % ((NINP - NIN) * (D / 8));
            ((v4u*)(ws + WS_W + (size_t)l * W_LAYER + WO_IN + (size_t)NIN * D * 2))[r] = (v4u){0u, 0u, 0u, 0u}; }
        norm_phase<1>(args.in[0], args.in[1], args.in[4], hbuf, args.in[5], xn, nullptr, gw, NGW, lane, nullptr, 0.f, D, G, lds, tid);
        SEAM(0);
    }

#define PH_LOCALS() int tid_p = wave * 64 + fresh_lane(); asm volatile("" : "+v"(tid_p)); const int lane_p = tid_p & 63; int gw_p = gw, ngw_p = NGW, G_ = gridDim.x, bx_ = blockIdx.x, vcu_p = vcu, l_p = l; \
        unsigned char* ws_p = ws; asm volatile("" : "+s"(gw_p), "+s"(ngw_p), "+s"(G_), "+s"(bx_), "+s"(vcu_p), "+s"(l_p), "+s"(ws_p)); \
        unsigned char* wl = ws_p + WS_W + (size_t)l_p * W_LAYER; bf16* hbuf_p = (bf16*)(ws_p + WS_H); float* xn_p = (float*)(ws_p + WS_XN); bf16* act_p = (bf16*)(ws_p + WS_ACT); bf16* proj_p = (bf16*)(ws_p + WS_PROJ); bf16* ymix_p = (bf16*)(ws_p + WS_YMIX); \
        (void)lane_p; (void)gw_p; (void)ngw_p; (void)G_; (void)bx_; (void)vcu_p; (void)wl; (void)hbuf_p; (void)xn_p; (void)act_p; (void)proj_p; (void)ymix_p;
#pragma nounroll
    for (int l = 0; l < DEPTH; ++l) {
        const int pb = 1 + 12 * l;
        if (IN(pb + 0)) { PH_LOCALS();
            pg8::Gemm g{hbuf_p, (const bf16*)(wl + WO_GU1), TP, NGU, D}; pg8::StaticOrder S; S.init(TP, NGU, D, G_, bx_);
            pg8::EpiSwiGLU E{act_p, FF, xn_p};
            pg8::gemm_phase<pg8::EpiSwiGLU, pg8::StaticOrder, true, true>(lds, g, S, E, wave);
            CONVERT_IN_TAIL(S.nwg % G_, CV0, CV1);
            SEAM(pb + 0);
        }
        if (IN(pb + 1)) { PH_LOCALS();
            pg8::Gemm g{act_p, (const bf16*)(wl + WO_DN1), TP, D, FF}; pg8::PanelTailOrder<TSP> S; S.init(TP, D, FF, G_, bx_);
            pg8::EpiResid E{hbuf_p, D, 0.5f, (float*)(ws_p + WS_SLAB), xn_p, (LAS float*)(lds + 131072)};
            pg8::gemm_phase<pg8::EpiResid, pg8::PanelTailOrder<TSP>, true, true>(lds, g, S, E, wave);
            CONVERT_IN_TAIL(S.ntail() * TSP, CV1, CV2);
            SEAM(pb + 1);
        }
        if (IN(pb + 2)) { PH_LOCALS(); norm_phase<0>(nullptr, nullptr, nullptr, hbuf_p, args.in[8] + (size_t)l_p * D, xn_p, nullptr, gw_p, ngw_p, lane_p, (const float*)(ws_p + WS_SLAB), 0.5f, FF, G_, lds, tid_p); SEAM(pb + 2); }
        if (IN(pb + 3)) { PH_LOCALS();
            pg8::Gemm g{hbuf_p, (const bf16*)(wl + WO_IN), TP, NINP, D}; pg8::StaticOrder S; S.init(TP, NINP, D, G_, bx_);
            pg8::EpiBf16 E{proj_p, NINP, xn_p};
            pg8::gemm_phase<pg8::EpiBf16, pg8::StaticOrder, true, true>(lds, g, S, E, wave);
            CONVERT_IN_TAIL(S.nwg % G_, CV2, CV3);
            SEAM(pb + 3);
        }
        if (IN(pb + 4)) { PH_LOCALS();
            if (G_ <= 32) conv_phase(proj_p, ymix_p, args.in[10] + (size_t)l_p * 3 * DCONV, args.in[11] + (size_t)l_p * DCONV, args.in[2] + (size_t)l_p * 128 * 2 * DCONV, args.out, l_p, gw_p, ngw_p, lane_p);
            else if (vcu_p >= 16) conv_phase(proj_p, ymix_p, args.in[10] + (size_t)l_p * 3 * DCONV, args.in[11] + (size_t)l_p * DCONV, args.in[2] + (size_t)l_p * 128 * 2 * DCONV, args.out, l_p, gw_p - 16 * NWAVES, ngw_p - 16 * NWAVES, lane_p);
            const GAS float* fw2 = (const GAS float*)args.in[12] + (size_t)l_p * GRANK * 512; const GAS float* fb = (const GAS float*)args.in[13] + (size_t)l_p * 512; const GAS float* gg = (const GAS float*)args.in[14] + (size_t)l_p * GDV;
            for (int it = vcu_p; it < 1040; it += G_) {
                const bool isp = it >= 512; const int j = isp ? it - 512 : it;
                const int bh = isp ? j / 33 : j, c = isp ? j - bh * 33 : 0, bi = bh >> 2, hd = bh & 3;
                if (!isp) gla_sample_item(lds, (const GAS bf16*)proj_p, (GAS bf16*)ymix_p, fw2, fb, gg, hd, bi, (const GAS float*)args.in[3] + ((size_t)l_p * 512 + bh) * GDK * GDV, (GAS float*)args.out + O_GS + ((size_t)l_p * 512 + bh) * GDK * GDV, wave);
                else gla_item_mfma(lds, (const GAS bf16*)proj_p, (GAS bf16*)ymix_p, fw2, fb, gg, hd, true, bi, c, nullptr, nullptr, wave,
                              (GAS bf16*)(ws_p + WS_GQS) + (size_t)j * 8192, (GAS bf16*)(ws_p + WS_GPL) + (size_t)j * 4096, (GAS float*)(ws_p + WS_GEBL) + (size_t)j * 128, (GAS float*)((GAS bf16*)(ws_p + WS_GU) + (size_t)j * 32768));
            }
            SEAM(pb + 4);
        }
        if (IN(pb + 5)) { PH_LOCALS();
            gla_scan_phase((const GAS float*)(ws_p + WS_GU), (const GAS float*)(ws_p + WS_GEBL), (GAS bf16*)(ws_p + WS_GS), (GAS float*)args.out + O_GP + (size_t)l_p * 16 * GDK * GDV, vcu_p * (NWAVES * 64) + tid_p, G_ * (NWAVES * 64));
            SEAM(pb + 5);
        }
        if (IN(pb + 6)) { PH_LOCALS();
            const GAS float* gg = (const GAS float*)args.in[14] + (size_t)l_p * GDV;
            for (int it = vcu_p; it < 528; it += G_) { const int bh = it < 512 ? (it >> 5) : it - 512, c = it < 512 ? 1 + (it & 31) : 0, j = bh * 33 + c;
                gla_passC_item(lds, (const GAS bf16*)proj_p, (GAS bf16*)ymix_p, gg, bh & 3, bh >> 2, c, wave,
                               (const GAS bf16*)(ws_p + WS_GQS) + (size_t)j * 8192, (const GAS bf16*)(ws_p + WS_GPL) + (size_t)j * 4096, (const GAS bf16*)(ws_p + WS_GS) + (size_t)j * 32768); }
            SEAM(pb + 6);
        }
        if (IN(pb + 7)) { PH_LOCALS();
            pg8::Gemm g{ymix_p, (const bf16*)(wl + WO_OUT), TP, D, D}; pg8::PanelTailOrder<TSP> S; S.init(TP, D, D, G_, bx_);
            pg8::EpiResid E{hbuf_p, D, 1.0f, (float*)(ws_p + WS_SLAB), xn_p, (LAS float*)(lds + 131072)};
            pg8::gemm_phase<pg8::EpiResid, pg8::PanelTailOrder<TSP>, true, true>(lds, g, S, E, wave);
            CONVERT_IN_TAIL(S.ntail() * TSP, CV3, CV4);
            SEAM(pb + 7);
        }
        if (IN(pb + 8)) { PH_LOCALS(); norm_phase<0>(nullptr, nullptr, nullptr, hbuf_p, args.in[16] + (size_t)l_p * D, xn_p, nullptr, gw_p, ngw_p, lane_p, (const float*)(ws_p + WS_SLAB), 1.0f, D, G_, lds, tid_p); SEAM(pb + 8); }
        if (IN(pb + 9)) { PH_LOCALS();
            pg8::Gemm g{hbuf_p, (const bf16*)(wl + WO_GU2), TP, NGU, D}; pg8::StaticOrder S; S.init(TP, NGU, D, G_, bx_);
            pg8::EpiSwiGLU E{act_p, FF, xn_p};
            pg8::gemm_phase<pg8::EpiSwiGLU, pg8::StaticOrder, true, true>(lds, g, S, E, wave);
            CONVERT_IN_TAIL(S.nwg % G_, CV4, CV5);
            SEAM(pb + 9);
        }
        if (IN(pb + 10)) { PH_LOCALS();
            pg8::Gemm g{act_p, (const bf16*)(wl + WO_DN2), TP, D, FF}; pg8::PanelTailOrder<TSP> S; S.init(TP, D, FF, G_, bx_);
            pg8::EpiResid E{hbuf_p, D, 0.5f, (float*)(ws_p + WS_SLAB), xn_p, (LAS float*)(lds + 131072)};
            pg8::gemm_phase<pg8::EpiResid, pg8::PanelTailOrder<TSP>, true, true>(lds, g, S, E, wave);
            CONVERT_IN_TAIL(S.ntail() * TSP, CV5, CV6);
            SEAM(pb + 10);
        }
        if (IN(pb + 11)) { PH_LOCALS();
            if (l_p + 1 < DEPTH) norm_phase<0>(nullptr, nullptr, nullptr, hbuf_p, args.in[5] + (size_t)(l_p + 1) * D, xn_p, nullptr, gw_p, ngw_p, lane_p, (const float*)(ws_p + WS_SLAB), 0.5f, FF, G_, lds, tid_p);
            else norm_phase<2>(nullptr, nullptr, nullptr, hbuf_p, args.in[19], nullptr, args.out, gw_p, ngw_p, lane_p, (const float*)(ws_p + WS_SLAB), 0.5f, FF, G_, lds, tid_p);
            SEAM(pb + 11);
        }
    }
#undef PH_LOCALS
#undef CONVERT_RANGE
#undef CONVERT_IN_TAIL
#undef IN
#undef SEAM
}

extern "C" void kernel_launch(void* const* d_in, const int* in_sizes, int n_in, void* d_out, int out_size, void* d_ws, size_t ws_size, hipStream_t stream) {
    static int grid = 0;
    if (grid == 0) {
        if (n_in != 20 || (size_t)out_size != O_END || ws_size < WS_END) { fprintf(stderr, "kernel_launch: unexpected shapes (n_in %d, out %d, ws %zu); nothing launched\n", n_in, out_size, ws_size); grid = -1; return; }
        int dev = 0, cus = 0, per_cu = 0;
        if (hipGetDevice(&dev) != hipSuccess || hipDeviceGetAttribute(&cus, hipDeviceAttributeMultiprocessorCount, dev) != hipSuccess) { grid = -1; return; }
        if (hipFuncSetAttribute((const void*)mk_fwd, hipFuncAttributeMaxDynamicSharedMemorySize, LDS_BYTES) != hipSuccess) { fprintf(stderr, "kernel_launch: hipFuncSetAttribute failed\n"); grid = -1; return; }
        if (hipOccupancyMaxActiveBlocksPerMultiprocessor(&per_cu, (const void*)mk_fwd, NWAVES * 64, LDS_BYTES) != hipSuccess || per_cu < 1)
            fprintf(stderr, "kernel_launch: occupancy query reports %d workgroups per CU\n", per_cu);
        (void)hipGetLastError();
        grid = cus;
        if (grid < 32) grid = 32;
    }
    if (grid < 0) return;
    (void)hipMemsetAsync((char*)d_ws + WS_CTL, 0, CTL_ZERO_BYTES, stream);
    Args a{};
    for (int i = 0; i < 20; ++i) a.in[i] = (const float*)d_in[i];
    a.out = (float*)d_out; a.ws = (unsigned char*)d_ws;
    if (MK_N_LAUNCHES == 1) {
        a.ph_lo = 0; a.ph_hi = N_PHASES;
        hipLaunchKernelGGL(mk_fwd, dim3(grid), dim3(NWAVES * 64), LDS_BYTES, stream, a);
    } else {
        for (int p = 0; p < N_PHASES; ++p) { a.ph_lo = p; a.ph_hi = p + 1; hipLaunchKernelGGL(mk_fwd, dim3(grid), dim3(NWAVES * 64), LDS_BYTES, stream, a); }
    }
}
```

```cpp
#include <hip/hip_runtime.h>
#include <cstdio>
#include <cstdint>

#ifndef MK_N_LAUNCHES
#define MK_N_LAUNCHES 1
#endif

__device__ __forceinline__ int fresh_lane() { unsigned z = 0u; asm volatile("" : "+s"(z)); return (int)__builtin_amdgcn_mbcnt_hi(~0u, __builtin_amdgcn_mbcnt_lo(~0u, z)); }
namespace pg8 {
#define PG8_LAS __attribute__((address_space(3)))
#define PG8_GAS __attribute__((address_space(1)))
typedef unsigned short bf16_t;
typedef short bf16x8 __attribute__((ext_vector_type(8)));
typedef float f32x4 __attribute__((ext_vector_type(4)));
typedef unsigned u32x4 __attribute__((ext_vector_type(4)));
constexpr int BM = 256, BK = 64, HALF = 128, HTB = HALF * BK * 2  , STAGE_BYTES = 8 * HTB, NXCD = 8, WGM = 8;

__host__ __device__ __forceinline__ int lds_byte(int r, int c) { const int st = (r >> 4) * 2 + (c >> 5), rr = r & 15, cc = c & 31, ob = rr * 64 + cc * 2; return st * 1024 + (ob ^ (((ob >> 9) & 1) << 5)); }
__host__ __device__ __forceinline__ void stage_rc(int b, int& R, int& C) { const int st = b / 1024, sb = b % 1024, swz = sb ^ (((sb >> 9) & 1) << 5); R = (st >> 1) * 16 + swz / 64; C = (st & 1) * 32 + (swz % 64) / 2; }
__host__ __device__ __forceinline__ int perm32(int rho) { const int n = rho >> 4, i = rho & 15; return 8 * (i >> 2) + 4 * n + (i & 3); }

struct Unit { int pm, pn, kt0, nkt, slab; };
struct Gemm { const bf16_t* A; const bf16_t* Bt; int M, N, K; };

struct StaticOrder {
    int nM, nN, nwg, G, c, nkt;
    __host__ __device__ void init(int M, int N, int K, int G_, int c_) { nM = M / BM; nN = N / BM; nwg = nM * nN; G = G_; c = c_; nkt = K / BK; }
    __host__ __device__ bool next(int i, Unit& u) const {
        const long L = (long)i * G + c; if (L >= nwg) return false;
        u.kt0 = 0; u.nkt = nkt; u.slab = -1;
        int wgid = (int)L; { const int q = nwg / NXCD, r = nwg % NXCD, xcd = wgid % NXCD, off = wgid / NXCD; wgid = (xcd < r ? xcd * (q + 1) : r * (q + 1) + (xcd - r) * q) + off; }
        const int nig = WGM * nN, gid = wgid / nig, fm = gid * WGM, gsz = (nM - fm) < WGM ? (nM - fm) : WGM;
        u.pm = fm + ((wgid % nig) % gsz); u.pn = (wgid % nig) / gsz; return true;
    }
    __device__ __forceinline__ void a_ready(const Unit&) const {}
    __device__ __forceinline__ void done(const Unit&) const {}
};

template <int SP> struct TailSplitOrder : StaticOrder {
    __host__ __device__ int ntail() const { return nwg % G; }
    __host__ __device__ int rounds() const { return nwg / G; }
    __host__ __device__ bool tail_unit(int tu, Unit& u) const { StaticOrder t = *this; t.c = tu; return t.next(rounds(), u); }
    __host__ __device__ bool next(int i, Unit& u) const {
        const int R = rounds(), nt = ntail();
        if (i < R) return StaticOrder::next(i, u);
        if (i > R || nt == 0) return false;
        if (nt * SP > G || (nkt % (2 * SP)) != 0) return StaticOrder::next(i, u);
        if (c >= nt * SP) return false;
        const int tu = c % nt, ks = c / nt;
        if (!tail_unit(tu, u)) return false;
        u.nkt = nkt / SP; u.kt0 = ks * u.nkt; u.slab = tu * SP + ks; return true;
    }
};

struct PairSplitOrder : StaticOrder {
    __host__ __device__ __forceinline__ int ntail() const { return nwg % G; }
    __host__ __device__ __forceinline__ int rounds() const { return nwg / G; }
    __host__ __device__ __forceinline__ bool split() const { const int nt = ntail(); return nt > 0 && 2 * nt <= G && (nkt % 4) == 0; }
    __host__ __device__ __forceinline__ int nbusy_last() const { return split() ? 2 * ntail() : ntail(); }
    __host__ __device__ __forceinline__ bool next(int i, Unit& u) const {
        const int R = rounds(), nt = ntail();
        if (i < R) return StaticOrder::next(i, u);
        if (i > R || nt == 0) return false;
        if (!split()) return StaticOrder::next(i, u);
        if (c >= 2 * nt) return false;
        const int tu = c % nt, ks = c / nt; StaticOrder t = *this; t.c = tu; if (!t.next(R, u)) return false;
        u.nkt = nkt / 2; u.kt0 = ks * u.nkt; u.slab = tu * 2 + ks; return true;
    }
};

typedef __bf16 bf16x2v __attribute__((ext_vector_type(2)));
typedef float f32x2v __attribute__((ext_vector_type(2)));
__device__ __forceinline__ unsigned cvt_pk_bf16(float lo, float hi) { const f32x2v v = {lo, hi}; const bf16x2v r = __builtin_convertvector(v, bf16x2v); return __builtin_bit_cast(unsigned, r); }

struct EpiBf16 {
    static constexpr bool PERM = true, AFTER_DRAIN = false;
    bf16_t* O; int ldc; const float* rs;
    __device__ __forceinline__ void operator()(const f32x4 (&acc)[2][2][4][2], const Unit& u, int wr, int wc, int fr, int fq) const {
        const int row0 = u.pm * BM + wr * 64 + fr; const int col0 = u.pn * BM + wc * 32 + 8 * fq;
#pragma unroll
        for (int ai = 0; ai < 2; ++ai)
#pragma unroll
            for (int m = 0; m < 4; ++m) { PG8_GAS bf16_t* rowp = (PG8_GAS bf16_t*)O + (size_t)(row0 + ai * HALF + m * 16) * ldc + col0; const float r = ((const PG8_GAS float*)rs)[row0 + ai * HALF + m * 16];
#pragma unroll
                for (int bj = 0; bj < 2; ++bj) { const f32x4 v0 = acc[ai][bj][m][0] * r, v1 = acc[ai][bj][m][1] * r;
                    u32x4 w; w.x = cvt_pk_bf16(v0[0], v0[1]); w.y = cvt_pk_bf16(v0[2], v0[3]); w.z = cvt_pk_bf16(v1[0], v1[1]); w.w = cvt_pk_bf16(v1[2], v1[3]);
                    *(PG8_GAS u32x4*)(rowp + bj * HALF) = w; } }
    }
};
struct EpiSwiGLU {
    static constexpr bool PERM = true, AFTER_DRAIN = false;
    bf16_t* O; int ldc; const float* rs; float* pslab; unsigned* pcnt;
    __device__ __forceinline__ static float silu_mul(float a, float b) { return a * __builtin_amdgcn_rcpf(1.0f + __builtin_amdgcn_exp2f(-1.44269504089f * a)) * b; }
    __device__ __forceinline__ void operator()(const f32x4 (&acc)[2][2][4][2], const Unit& u, int wr, int wc, int fr, int fq) const {
        const int row0 = u.pm * BM + wr * 64 + fr; const int col0 = u.pn * HALF + wc * 32 + 8 * fq;
        const PG8_GAS f32x4* sp = (const PG8_GAS f32x4*)pslab + (size_t)(u.slab < 0 ? 0 : (u.slab >> 1)) * (32 * 512) + ((wr * 4 + wc) * 64 + fq * 16 + fr);
        if (u.slab >= 0 && !(u.slab & 1)) {
#pragma unroll
            for (int ai = 0; ai < 2; ++ai)
#pragma unroll
                for (int bj = 0; bj < 2; ++bj)
#pragma unroll
                    for (int m = 0; m < 4; ++m)
#pragma unroll
                        for (int n = 0; n < 2; ++n) ((PG8_GAS f32x4*)sp)[(size_t)(((ai * 2 + bj) * 4 + m) * 2 + n) * 512] = acc[ai][bj][m][n];
            asm volatile("s_waitcnt vmcnt(0)" ::: "memory");
            __builtin_amdgcn_s_barrier(); asm volatile("" ::: "memory");
            if (wr == 0 && wc == 0 && fr == 0 && fq == 0) { __builtin_amdgcn_fence(__ATOMIC_RELEASE, "agent"); asm volatile("s_waitcnt vmcnt(0)" ::: "memory");
                __hip_atomic_fetch_add(pcnt + 64 * (u.slab >> 1), 1u, __ATOMIC_RELAXED, __HIP_MEMORY_SCOPE_AGENT); }
            return;
        }
        const bool add = u.slab >= 0;
        if (add) { unsigned spn = 0;
            while ((unsigned)__builtin_amdgcn_readfirstlane(__hip_atomic_load(pcnt + 64 * (u.slab >> 1), __ATOMIC_RELAXED, __HIP_MEMORY_SCOPE_AGENT)) < 1u) { __builtin_amdgcn_s_sleep(2); if (++spn > (1u << 22)) break; }
            __builtin_amdgcn_fence(__ATOMIC_ACQUIRE, "agent"); asm volatile("s_waitcnt vmcnt(0)" ::: "memory"); }
#pragma unroll
        for (int ai = 0; ai < 2; ++ai)
#pragma unroll
            for (int m = 0; m < 4; ++m) { PG8_GAS bf16_t* rowp = (PG8_GAS bf16_t*)O + (size_t)(row0 + ai * HALF + m * 16) * ldc + col0;
                const float r = ((const PG8_GAS float*)rs)[row0 + ai * HALF + m * 16];
                f32x4 g0 = acc[ai][0][m][0], g1 = acc[ai][0][m][1], u0 = acc[ai][1][m][0], u1 = acc[ai][1][m][1];
                if (add) { g0 += sp[(size_t)(((ai * 2 + 0) * 4 + m) * 2 + 0) * 512]; g1 += sp[(size_t)(((ai * 2 + 0) * 4 + m) * 2 + 1) * 512]; u0 += sp[(size_t)(((ai * 2 + 1) * 4 + m) * 2 + 0) * 512]; u1 += sp[(size_t)(((ai * 2 + 1) * 4 + m) * 2 + 1) * 512]; }
                const f32x4 a0 = g0 * r, a1 = g1 * r, b0 = u0 * r, b1 = u1 * r;
                f32x4 e0, e1;
#pragma unroll
                for (int j = 0; j < 4; ++j) { e0[j] = __builtin_amdgcn_exp2f(-1.44269504089f * a0[j]); e1[j] = __builtin_amdgcn_exp2f(-1.44269504089f * a1[j]); }
                f32x4 r0, r1;
#pragma unroll
                for (int j = 0; j < 4; ++j) { r0[j] = __builtin_amdgcn_rcpf(1.0f + e0[j]); r1[j] = __builtin_amdgcn_rcpf(1.0f + e1[j]); }
                const f32x4 s0 = a0 * r0 * b0, s1 = a1 * r1 * b1;
                u32x4 w; w.x = cvt_pk_bf16(s0[0], s0[1]); w.y = cvt_pk_bf16(s0[2], s0[3]); w.z = cvt_pk_bf16(s1[0], s1[1]); w.w = cvt_pk_bf16(s1[2], s1[3]);
                *(PG8_GAS u32x4*)rowp = w; }
    }
};
struct EpiResid {
    static constexpr bool PERM = false, AFTER_DRAIN = false;
    bf16_t* C; int ldc; float scale; float* slabs;
    __device__ __forceinline__ void operator()(const f32x4 (&acc)[2][2][4][2], const Unit& u, int wr, int wc, int fr, int fq) const {
        if (u.slab >= 0) {
            typedef unsigned u32x2 __attribute__((ext_vector_type(2)));
            PG8_GAS bf16_t* sp = (PG8_GAS bf16_t*)slabs + (size_t)u.slab * (BM * BM) + (size_t)(wr * 64 + fr) * BM + wc * 32 + 4 * fq;
#pragma unroll
            for (int ai = 0; ai < 2; ++ai)
#pragma unroll
                for (int m = 0; m < 4; ++m)
#pragma unroll
                    for (int bj = 0; bj < 2; ++bj)
#pragma unroll
                        for (int n = 0; n < 2; ++n) { const f32x4 v = acc[ai][bj][m][n]; *(PG8_GAS u32x2*)(sp + (size_t)(ai * HALF + m * 16) * BM + bj * HALF + n * 16) = (u32x2){cvt_pk_bf16(v[0], v[1]), cvt_pk_bf16(v[2], v[3])}; }
            return;
        }
        const int row0 = u.pm * BM + wr * 64 + fr, col0 = u.pn * BM + wc * 32 + 4 * fq;
        typedef unsigned u32x2 __attribute__((ext_vector_type(2)));
        u32x2 old[2][4][2][2];
#pragma unroll
        for (int ai = 0; ai < 2; ++ai)
#pragma unroll
            for (int m = 0; m < 4; ++m) { const PG8_GAS bf16_t* rowp = (const PG8_GAS bf16_t*)C + (size_t)(row0 + ai * HALF + m * 16) * ldc + col0;
#pragma unroll
                for (int bj = 0; bj < 2; ++bj)
#pragma unroll
                    for (int n = 0; n < 2; ++n) old[ai][m][bj][n] = *(const PG8_GAS u32x2*)(rowp + bj * HALF + n * 16); }
#pragma unroll
        for (int ai = 0; ai < 2; ++ai)
#pragma unroll
            for (int m = 0; m < 4; ++m) { PG8_GAS bf16_t* rowp = (PG8_GAS bf16_t*)C + (size_t)(row0 + ai * HALF + m * 16) * ldc + col0;
#pragma unroll
                for (int bj = 0; bj < 2; ++bj)
#pragma unroll
                    for (int n = 0; n < 2; ++n) { const u32x2 o = old[ai][m][bj][n]; const f32x4 a = acc[ai][bj][m][n];
                        const float y0 = __builtin_bit_cast(float, o.x << 16) + a[0] * scale, y1 = __builtin_bit_cast(float, o.x & 0xffff0000u) + a[1] * scale;
                        const float y2 = __builtin_bit_cast(float, o.y << 16) + a[2] * scale, y3 = __builtin_bit_cast(float, o.y & 0xffff0000u) + a[3] * scale;
                        *(PG8_GAS u32x2*)(rowp + bj * HALF + n * 16) = (u32x2){cvt_pk_bf16(y0, y1), cvt_pk_bf16(y2, y3)}; } }
    }
};

template <class Epi, class Sched, bool ALIGN_EPI = false, bool SP2 = false>
__device__ __forceinline__ void gemm_phase(PG8_LAS unsigned char* lds, const Gemm g, const Sched& S, const Epi& E, const int wave_id) {
    int tid_ = wave_id * 64 + fresh_lane(); asm volatile("" : "+v"(tid_));
    const int tid = tid_, wid = __builtin_amdgcn_readfirstlane(tid >> 6), lane = tid & 63, wr = wid >> 2, wc = wid & 3, fr = lane & 15, fq = lane >> 4;
    const int K = g.K;
    unsigned voffA[2], voffB[2];
#pragma unroll
    for (int i = 0; i < 2; ++i) { int R, C; stage_rc(tid * 16 + i * 8192, R, C); const int Rb = Epi::PERM ? ((R & ~31) + perm32(R & 31)) : R;
        voffA[i] = (unsigned)(R * K + C) * 2u; voffB[i] = (unsigned)(Rb * K + C) * 2u; }
    const size_t kstep = (size_t)(BK * 2);
    const size_t hstep = (size_t)HALF * K * 2;
    const size_t tstep = 2 * hstep;
    const unsigned ldsw = (unsigned)wid * 1024u;
    const int aoff = lds_byte(wr * 64 + fr, fq * 8), boff = lds_byte(wc * 32 + fr, fq * 8);
#define PG8_SA(b, h) (((b) * 2 + (h)) * HTB)
#define PG8_SB(b, h) ((4 + (b) * 2 + (h)) * HTB)
#define PG8_STAGE(bufoff, gbase, voff) do { _Pragma("unroll") for (int _i = 0; _i < 2; ++_i) \
        __builtin_amdgcn_global_load_lds((const unsigned*)((const char*)(gbase) + (voff)[_i]), (PG8_LAS unsigned*)(lds + (bufoff) + ldsw + _i * 8192), 16, 0, 0); } while (0)
#define PG8_LDA(dst, b, h) do { _Pragma("unroll") for (int m = 0; m < 4; ++m) _Pragma("unroll") for (int k = 0; k < 2; ++k) dst[m][k] = *(const PG8_LAS bf16x8*)(lds + PG8_SA(b, h) + aoff + m * 2048 + k * 1024); } while (0)
#define PG8_LDB(dst, b, h) do { _Pragma("unroll") for (int n = 0; n < 2; ++n) _Pragma("unroll") for (int k = 0; k < 2; ++k) dst[n][k] = *(const PG8_LAS bf16x8*)(lds + PG8_SB(b, h) + boff + n * 2048 + k * 1024); } while (0)
#define PG8_MMA(ai, bj, At, Bt) do { __builtin_amdgcn_s_setprio(1); _Pragma("unroll") for (int m = 0; m < 4; ++m) _Pragma("unroll") for (int n = 0; n < 2; ++n) _Pragma("unroll") for (int k = 0; k < 2; ++k) \
        acc[ai][bj][m][n] = __builtin_amdgcn_mfma_f32_16x16x32_bf16(Bt[n][k], At[m][k], acc[ai][bj][m][n], 0, 0, 0); __builtin_amdgcn_s_setprio(0); } while (0)
#define PG8_WAIT_V(n) asm volatile("s_waitcnt vmcnt(" #n ")" ::: "memory")
#define PG8_WAIT_L(n) asm volatile("s_waitcnt lgkmcnt(" #n ")" ::: "memory")
#define PG8_BAR __builtin_amdgcn_s_barrier()
#define PG8_SCHED __builtin_amdgcn_sched_barrier(0)
    Unit cur, nxt; int ui = 0;
    if (!S.next(0, cur)) return;
    f32x4 acc[2][2][4][2];
#pragma unroll
    for (int a = 0; a < 2; ++a)
#pragma unroll
        for (int b = 0; b < 2; ++b)
#pragma unroll
            for (int m = 0; m < 4; ++m)
#pragma unroll
                for (int n = 0; n < 2; ++n) acc[a][b][m][n] = (f32x4){0.f, 0.f, 0.f, 0.f};
    bf16x8 At[4][2], B0[2][2], B1[2][2];
    const char* cA = (const char*)g.A + (size_t)cur.pm * tstep + (size_t)cur.kt0 * kstep; const char* cB = (const char*)g.Bt + (size_t)cur.pn * tstep + (size_t)cur.kt0 * kstep;
    S.a_ready(cur);
    if constexpr (SP2) {
        PG8_STAGE(PG8_SB(0, 0), cB, voffB); PG8_STAGE(PG8_SB(0, 1), cB + hstep, voffB); PG8_STAGE(PG8_SA(0, 0), cA, voffA); PG8_STAGE(PG8_SA(0, 1), cA + hstep, voffA);
        if (wr == 1) PG8_BAR;
        PG8_WAIT_V(2); PG8_BAR;
        PG8_STAGE(PG8_SB(1, 0), cB + kstep, voffB); PG8_STAGE(PG8_SA(1, 0), cA + kstep, voffA); PG8_STAGE(PG8_SB(1, 1), cB + hstep + kstep, voffB);
        PG8_WAIT_V(6); PG8_BAR;
    } else {
        PG8_STAGE(PG8_SB(0, 0), cB, voffB); PG8_STAGE(PG8_SA(0, 0), cA, voffA); PG8_STAGE(PG8_SB(0, 1), cB + hstep, voffB); PG8_STAGE(PG8_SA(0, 1), cA + hstep, voffA);
        if (wr == 1) PG8_BAR;
        PG8_WAIT_V(4); PG8_BAR;
        PG8_STAGE(PG8_SB(1, 0), cB + kstep, voffB); PG8_STAGE(PG8_SA(1, 0), cA + kstep, voffA); PG8_STAGE(PG8_SB(1, 1), cB + hstep + kstep, voffB);
        PG8_WAIT_V(6); PG8_BAR;
    }
    for (;;) {
        const bool has_next = S.next(ui + 1, nxt);
        const char* nA = has_next ? (const char*)g.A + (size_t)nxt.pm * tstep + (size_t)nxt.kt0 * kstep : cA; const char* nB = has_next ? (const char*)g.Bt + (size_t)nxt.pn * tstep + (size_t)nxt.kt0 * kstep : cB;
        const int nt = cur.nkt;
        for (int t = 0; t < nt; t += 2) {
            const bool last = (t == nt - 2);
            const char* a1 = cA + (size_t)(t + 1) * kstep;
            const char* a2 = last ? nA : cA + (size_t)(t + 2) * kstep; const char* b2 = last ? nB : cB + (size_t)(t + 2) * kstep;
            const char* a3 = a2 + kstep; const char* b3 = b2 + kstep;
            if (last && has_next) S.a_ready(nxt);
            if constexpr (SP2) {
            PG8_LDB(B0, 0, 0); PG8_LDB(B1, 0, 1); PG8_SCHED; PG8_LDA(At, 0, 0); PG8_STAGE(PG8_SA(1, 1), a1 + hstep, voffA);
            PG8_WAIT_V(8); PG8_WAIT_L(0); PG8_BAR; PG8_MMA(0, 0, At, B0); PG8_MMA(0, 1, At, B1); PG8_BAR; PG8_SCHED;
            PG8_LDA(At, 0, 1); PG8_STAGE(PG8_SB(0, 0), b2, voffB); PG8_STAGE(PG8_SB(0, 1), b2 + hstep, voffB); PG8_STAGE(PG8_SA(0, 0), a2, voffA);
            PG8_WAIT_V(8); PG8_WAIT_L(0); PG8_BAR; PG8_MMA(1, 0, At, B0); PG8_MMA(1, 1, At, B1); PG8_BAR; PG8_SCHED;
            PG8_LDB(B0, 1, 0); PG8_LDB(B1, 1, 1); PG8_SCHED; PG8_LDA(At, 1, 0); PG8_STAGE(PG8_SA(0, 1), a2 + hstep, voffA);
            PG8_WAIT_V(8); PG8_WAIT_L(0); PG8_BAR; PG8_MMA(0, 0, At, B0); PG8_MMA(0, 1, At, B1); PG8_BAR; PG8_SCHED;
            PG8_LDA(At, 1, 1); PG8_STAGE(PG8_SB(1, 0), b3, voffB); PG8_STAGE(PG8_SB(1, 1), b3 + hstep, voffB); PG8_STAGE(PG8_SA(1, 0), a3, voffA);
            PG8_WAIT_V(8); PG8_WAIT_L(0); PG8_BAR; PG8_MMA(1, 0, At, B0); PG8_MMA(1, 1, At, B1); PG8_BAR; PG8_SCHED;
            } else {
            PG8_LDB(B0, 0, 0); PG8_SCHED; PG8_LDA(At, 0, 0); PG8_STAGE(PG8_SA(1, 1), a1 + hstep, voffA);
            PG8_WAIT_L(8); PG8_BAR; PG8_WAIT_L(0); PG8_MMA(0, 0, At, B0); PG8_BAR; PG8_SCHED;
            PG8_LDB(B1, 0, 1); PG8_STAGE(PG8_SB(0, 0), b2, voffB);
            PG8_BAR; PG8_WAIT_L(0); PG8_MMA(0, 1, At, B1); PG8_BAR;
            PG8_LDA(At, 0, 1); PG8_STAGE(PG8_SA(0, 0), a2, voffA);
            PG8_BAR; PG8_WAIT_L(0); PG8_MMA(1, 0, At, B0); PG8_BAR; PG8_SCHED;
            PG8_STAGE(PG8_SB(0, 1), b2 + hstep, voffB);
            PG8_WAIT_V(6); PG8_BAR; PG8_MMA(1, 1, At, B1); PG8_BAR;
            PG8_LDB(B0, 1, 0); PG8_SCHED; PG8_LDA(At, 1, 0); PG8_STAGE(PG8_SA(0, 1), a2 + hstep, voffA);
            PG8_WAIT_L(8); PG8_BAR; PG8_WAIT_L(0); PG8_MMA(0, 0, At, B0); PG8_BAR; PG8_SCHED;
            PG8_LDB(B1, 1, 1); PG8_STAGE(PG8_SB(1, 0), b3, voffB);
            PG8_BAR; PG8_WAIT_L(0); PG8_MMA(0, 1, At, B1); PG8_BAR;
            PG8_LDA(At, 1, 1); PG8_STAGE(PG8_SA(1, 0), a3, voffA);
            PG8_BAR; PG8_WAIT_L(0); PG8_MMA(1, 0, At, B0); PG8_BAR; PG8_SCHED;
            PG8_STAGE(PG8_SB(1, 1), b3 + hstep, voffB);
            PG8_WAIT_V(6); PG8_BAR; PG8_MMA(1, 1, At, B1); PG8_BAR;
            }
        }
        if constexpr (ALIGN_EPI) { if (wr == 0) PG8_BAR; }
        if constexpr (!Epi::AFTER_DRAIN) { E(acc, cur, wr, wc, fr, fq); S.done(cur); }
        if (!has_next) break;
#pragma unroll
        for (int a = 0; a < 2; ++a)
#pragma unroll
            for (int b = 0; b < 2; ++b)
#pragma unroll
                for (int m = 0; m < 4; ++m)
#pragma unroll
                    for (int n = 0; n < 2; ++n) acc[a][b][m][n] = (f32x4){0.f, 0.f, 0.f, 0.f};
        cur = nxt; cA = nA; cB = nB; ++ui;
        if constexpr (ALIGN_EPI) { if (wr == 1) PG8_BAR; }
    }
    PG8_WAIT_V(0);
    if constexpr (!ALIGN_EPI) { if (wr == 0) PG8_BAR; }
    PG8_BAR;
#undef PG8_SA
#undef PG8_SB
#undef PG8_STAGE
#undef PG8_LDA
#undef PG8_LDB
#undef PG8_MMA
#undef PG8_WAIT_V
#undef PG8_WAIT_L
#undef PG8_BAR
#undef PG8_SCHED
}
}

constexpr int NWAVES = 8;
constexpr int D = 2048, FF = 5632, NGU = 2 * FF, DEPTH = 4;
constexpr int DCONV = 1024, GH = 4, GDK = 128, GDV = 256, GRANK = 16;
constexpr int NIN = 6160, NINP = 6400;
constexpr int R_SAMPLE = 8192, R_META = 9216, T_REAL = 9280, TP = 9472;
constexpr int PC_B = 0, PC_C = 1024, PC_H = 2048, PC_Q = 3072, PC_K = 3584, PC_V = 4096, PC_GO = 5120, PC_FL = 6144;
constexpr float EPS = 1e-6f;
constexpr size_t O_YP = 0, O_YS = 16777216, O_GP = 18874368, O_CP = 20971520, O_GS = 21004288, O_CS = 88113152, O_END = 89161728;
constexpr size_t MiB = 1u << 20;
constexpr size_t WS_CTL = 0, CTL_ZERO_BYTES = 262144;
constexpr size_t WS_W = 2 * MiB, W_LAYER = 165 * MiB;
constexpr size_t WO_GU1 = 0, WO_DN1 = 44 * MiB, WO_IN = 66 * MiB, WO_OUT = 91 * MiB, WO_GU2 = 99 * MiB, WO_DN2 = 143 * MiB;
constexpr size_t WS_H = 664 * MiB, WS_XN = 738 * MiB, WS_ACT = 776 * MiB, WS_PROJ = 878 * MiB, WS_YMIX = 994 * MiB, WS_SLAB = 1032 * MiB, WS_GQS = 1096 * MiB, WS_GPL = 1105 * MiB, WS_GEBL = 1110 * MiB, WS_GU = 1111 * MiB, WS_GS = 1177 * MiB, WS_END = 1210 * MiB;
static_assert(WS_W + DEPTH * W_LAYER <= WS_H && WS_H + (size_t)TP * D * 4 <= WS_XN && WS_XN + (size_t)TP * D * 2 <= WS_ACT && WS_ACT + (size_t)TP * FF * 2 <= WS_PROJ &&
              WS_PROJ + (size_t)TP * NINP * 2 <= WS_YMIX && WS_YMIX + (size_t)TP * D * 2 <= WS_SLAB && WS_SLAB + (size_t)256 * 65536 * 4 <= WS_GQS && WS_GQS + (size_t)528 * 16384 <= WS_GPL && WS_GPL + (size_t)528 * 8192 <= WS_GEBL && WS_GEBL + (size_t)528 * 512 <= WS_GU && WS_GU + (size_t)528 * 131072 <= WS_GS && WS_GS + (size_t)528 * 65536 <= WS_END, "d_ws map");
constexpr int TSP = 4;
constexpr int CW_BAR = 4096;
constexpr int CW_GCNT = 16384, GCNT_STRIDE = 92 * 64;
static_assert((CW_GCNT + 8 * GCNT_STRIDE) * 4 <= (int)CTL_ZERO_BYTES, "CTL map");
static_assert((CW_BAR + 3456) * 4 <= (int)CTL_ZERO_BYTES, "the per-call memset covers the barrier words");
constexpr int LDS_BYTES = 147456, MISC_OFF = 143360;

#define GAS __attribute__((address_space(1)))
#define LAS __attribute__((address_space(3)))
typedef unsigned short bf16;
typedef unsigned v4u __attribute__((ext_vector_type(4)));
typedef unsigned v2u __attribute__((ext_vector_type(2)));
typedef float f32x4 __attribute__((ext_vector_type(4)));
typedef float f32x2 __attribute__((ext_vector_type(2)));
#define DI __device__ __forceinline__
#define LDS_WAIT() asm volatile("s_waitcnt lgkmcnt(0)" ::: "memory")
DI unsigned f2bf(float f) { unsigned u = __builtin_bit_cast(unsigned, f); return (u + 0x7fffu + ((u >> 16) & 1u)) >> 16; }
typedef __bf16 bf16x2_t __attribute__((ext_vector_type(2)));
DI unsigned pk2(float lo, float hi) { f32x2 v = {lo, hi}; bf16x2_t r = __builtin_convertvector(v, bf16x2_t); return __builtin_bit_cast(unsigned, r); }
DI float bflo(unsigned w) { return __uint_as_float(w << 16); }
DI float bfhi(unsigned w) { return __uint_as_float(w & 0xffff0000u); }

#define XB_TMO      128
#define XB_XCNT(j)  (256  + 64 * (j))
#define XB_XSUB(j)  (1280 + 64 * (j))
#define XB_XGEN(j)  (2304 + 64 * (j))
#define XB_TOP      3328
#define XB_TOPGEN   3392
#define XCD_BAR_WORDS 3456
#define XB_SPIN_CAP (1u << 22)
__device__ __forceinline__ unsigned xb_ld(unsigned* p)              { return __hip_atomic_load(p, __ATOMIC_RELAXED, __HIP_MEMORY_SCOPE_AGENT); }
__device__ __forceinline__ unsigned xb_add(unsigned* p, unsigned v) { return __hip_atomic_fetch_add(p, v, __ATOMIC_RELAXED, __HIP_MEMORY_SCOPE_AGENT); }
__device__ __forceinline__ unsigned xb_xcc_id() { return (unsigned)__builtin_amdgcn_s_getreg((3 << 11) | 20) & 0xFu; }
#define XB_SPIN(cond, bar) do { unsigned _sp = 0; while (cond) { __builtin_amdgcn_s_sleep(1); \
    if ((++_sp & 255u) == 0u) { if (xb_ld(&(bar)[XB_TMO])) break; if (_sp > XB_SPIN_CAP) { atomicAdd(&(bar)[XB_TMO], 1u); break; } } } } while (0)
struct XcdBarrier { unsigned* bar; unsigned x; volatile LAS unsigned* st; };
__device__ __forceinline__ bool xb_t0(int wave_id) { return wave_id == 0 && fresh_lane() == 0; }
__device__ __forceinline__ XcdBarrier xcd_barrier_post(unsigned* bar, volatile LAS unsigned* st, int wave_id) {
    XcdBarrier b; b.bar = bar; b.x = xb_xcc_id(); b.st = st;
    if (xb_t0(wave_id)) (void)xb_add(&bar[XB_XCNT(b.x)], 1u);
    return b;
}
__device__ __forceinline__ void xcd_barrier_complete(unsigned* bar, unsigned x, unsigned& nloc, unsigned& nx) {
    const unsigned G = gridDim.x * gridDim.y * gridDim.z;
    unsigned sum, cnt, mine, sp = 0u;
    for (;;) {
        sum = 0u; cnt = 0u; mine = 0u;
#pragma unroll
        for (unsigned j = 0; j < 16; ++j) { const unsigned c = xb_ld(&bar[XB_XCNT(j)]); sum += c; cnt += (c > 0u) ? 1u : 0u; mine = (j == x) ? c : mine; }
        if (sum == G) break;
        __builtin_amdgcn_s_sleep(1);
        if ((++sp & 255u) == 0u) { if (xb_ld(&bar[XB_TMO])) break; if (sp > XB_SPIN_CAP) { atomicAdd(&bar[XB_TMO], 1u); break; } }
    }
    nloc = mine > 0u ? mine : 1u; nx = cnt > 0u ? cnt : 1u;
}
__device__ __forceinline__ void xcd_barrier(const XcdBarrier& b, int wave_id) {
    asm volatile("s_waitcnt vmcnt(0)" ::: "memory");
    __syncthreads();
    if (xb_t0(wave_id)) {
        unsigned* bar = b.bar;
        __builtin_amdgcn_s_waitcnt(0);
        unsigned nloc = b.st[0], nx = b.st[1];
        if (nloc == 0u) { xcd_barrier_complete(bar, b.x, nloc, nx); b.st[0] = nloc; b.st[1] = nx; }
        const unsigned old = xb_add(&bar[XB_XSUB(b.x)], 1u);
        const unsigned gen = old / nloc;
        if (old + 1u == (gen + 1u) * nloc) {
            __builtin_amdgcn_fence(__ATOMIC_RELEASE, "agent");
            asm volatile("s_waitcnt vmcnt(0)" ::: "memory");
            const unsigned og = xb_add(&bar[XB_TOP], 1u);
            const unsigned tg = og / nx;
            if (og + 1u == (tg + 1u) * nx) xb_add(&bar[XB_TOPGEN], 1u);
            else XB_SPIN(xb_ld(&bar[XB_TOPGEN]) == tg, bar);
            __builtin_amdgcn_fence(__ATOMIC_ACQUIRE, "agent");
            xb_add(&bar[XB_XGEN(b.x)], 1u);
            asm volatile("s_waitcnt vmcnt(0)" ::: "memory");
        } else {
            XB_SPIN(xb_ld(&bar[XB_XGEN(b.x)]) == gen, bar);
            __builtin_amdgcn_fence(__ATOMIC_ACQUIRE, "agent");
            asm volatile("s_waitcnt vmcnt(0)" ::: "memory");
        }
    }
    __syncthreads();
}

DI float wave_sum(float v) {
#pragma unroll
    for (int o = 1; o < 64; o <<= 1) v += __shfl_xor(v, o);
    return v;
}
DI int row_prompt(int b, int pos) { return pos < 16 ? R_META + b * 16 + pos : b * 2048 + pos - 16; }

DI int dst_row(int kind, int n) { if (kind == 0) return n; const int a = n < FF ? n : n - FF; return 256 * (a >> 7) + (n < FF ? 0 : 128) + (a & 127); }
struct CvItem { const float* W; bf16* WT; int K, N, kind, kb, nb; const float* G; };
DI void cv_load(const CvItem& it, int lane, f32x4 (&v)[16], f32x4 (&g)[2]) {
    const int k0 = 64 * it.kb, n0 = 64 * it.nb, lr = lane >> 4, lc = 4 * (lane & 15);
    const bool inb = (n0 + lc) < it.N;
#pragma unroll
    for (int i = 0; i < 16; ++i) v[i] = inb ? __builtin_nontemporal_load((const f32x4*)(it.W + (size_t)(k0 + 4 * i + lr) * it.N + n0 + lc)) : (f32x4){0.f, 0.f, 0.f, 0.f};
    if (it.G) { g[0] = *(const f32x4*)(it.G + k0 + 8 * (lane & 7)); g[1] = *(const f32x4*)(it.G + k0 + 8 * (lane & 7) + 4); } else { g[0] = (f32x4){1.f, 1.f, 1.f, 1.f}; g[1] = g[0]; }
}
DI void cv_finish(const CvItem& it, const f32x4 (&v)[16], const f32x4 (&g)[2], LAS float* scr, int lane) {
    const int k0 = 64 * it.kb, n0 = 64 * it.nb, lr = lane >> 4, lc = 4 * (lane & 15);
#pragma unroll
    for (int i = 0; i < 16; ++i) { LAS float* s = scr + (4 * i + lr) * 65 + lc; s[0] = v[i][0]; s[1] = v[i][1]; s[2] = v[i][2]; s[3] = v[i][3]; }
    LDS_WAIT(); asm volatile("" ::: "memory");
    const int c = lane & 7;
#pragma unroll
    for (int j = 0; j < 8; ++j) { const int nl = (lane >> 3) + 8 * j, n = n0 + nl; const LAS float* s = scr + (8 * c) * 65 + nl;
        v4u o; o.x = pk2(s[0 * 65] * g[0][0], s[1 * 65] * g[0][1]); o.y = pk2(s[2 * 65] * g[0][2], s[3 * 65] * g[0][3]); o.z = pk2(s[4 * 65] * g[1][0], s[5 * 65] * g[1][1]); o.w = pk2(s[6 * 65] * g[1][2], s[7 * 65] * g[1][3]);
        if (n < it.N) *(v4u*)(it.WT + (size_t)dst_row(it.kind, n) * it.K + k0 + 8 * c) = o; }
    LDS_WAIT(); asm volatile("" ::: "memory");
}
constexpr int I_GU = 32 * 176, I_DN = 88 * 32, I_IN = 32 * 97, I_OUT = 32 * 32, I_LAYER = 2 * I_GU + 2 * I_DN + I_IN + I_OUT;
DI CvItem cv_decode(const float* g1, const float* d1, const float* wi, const float* wo, const float* g2, const float* d2, const float* n1, const float* nm, const float* n2, unsigned char* wbase, int g) {
    const int l = g / I_LAYER; int r = g - l * I_LAYER; unsigned char* wl = wbase + (size_t)l * W_LAYER;
    if (r < I_GU) return CvItem{g1 + (size_t)l * D * NGU, (bf16*)(wl + WO_GU1), D, NGU, 1, r / 176, r % 176, n1 + (size_t)l * D}; r -= I_GU;
    if (r < I_DN) return CvItem{d1 + (size_t)l * FF * D, (bf16*)(wl + WO_DN1), FF, D, 0, r / 32, r % 32, nullptr}; r -= I_DN;
    if (r < I_IN) return CvItem{wi + (size_t)l * D * NIN, (bf16*)(wl + WO_IN), D, NIN, 0, r / 97, r % 97, nm + (size_t)l * D}; r -= I_IN;
    if (r < I_OUT) return CvItem{wo + (size_t)l * D * D, (bf16*)(wl + WO_OUT), D, D, 0, r / 32, r % 32, nullptr}; r -= I_OUT;
    if (r < I_GU) return CvItem{g2 + (size_t)l * D * NGU, (bf16*)(wl + WO_GU2), D, NGU, 1, r / 176, r % 176, n2 + (size_t)l * D}; r -= I_GU;
    return CvItem{d2 + (size_t)l * FF * D, (bf16*)(wl + WO_DN2), FF, D, 0, r / 32, r % 32, nullptr};
}
DI void convert_range(const float* g1, const float* d1, const float* wi, const float* wo, const float* g2, const float* d2, const float* n1, const float* nm, const float* n2, unsigned char* wl, int ib, int ie, int widx, int wstride, LAS float* scr, int lane) {
    int it = ib + widx; if (it >= ie) return;
    CvItem cur = cv_decode(g1, d1, wi, wo, g2, d2, n1, nm, n2, wl, it), nx = cur; f32x4 va[16], vb[16], ga[2], gb[2];
    cv_load(cur, lane, va, ga);
    for (;;) {
        bool has = it + wstride < ie;
        if (has) { nx = cv_decode(g1, d1, wi, wo, g2, d2, n1, nm, n2, wl, it + wstride); cv_load(nx, lane, vb, gb); }
        cv_finish(cur, va, ga, scr, lane);
        if (!has) break;
        it += wstride; cur = nx;
        has = it + wstride < ie;
        if (has) { nx = cv_decode(g1, d1, wi, wo, g2, d2, n1, nm, n2, wl, it + wstride); cv_load(nx, lane, va, ga); }
        cv_finish(cur, vb, gb, scr, lane);
        if (!has) break;
        it += wstride; cur = nx;
    }
}

template <int MODE>
DI bool norm_load(int row, const GAS float* xp, const GAS float* xs, const GAS float* meta, GAS bf16* h, GAS float* rs, const GAS float* slabs, float scale, LAS int* tmap, int lane, f32x4 (&v)[8]) {
    if (row >= TP) return false;
    if (row >= T_REAL) {
        if (MODE != 2) {
#pragma unroll
            for (int j = 0; j < 8; ++j) { if (MODE == 1) ((GAS v2u*)(h + (size_t)row * D))[lane + 64 * j] = (v2u){0u, 0u}; }
            if (lane == 0) rs[row] = 0.f;
        }
        return false;
    }
    if (MODE == 2 && row >= R_META) return false;
    if (MODE == 1) {
        const GAS float* src = row < R_SAMPLE ? xp + (size_t)row * D : (row < R_META ? xs + (size_t)(row - R_SAMPLE) * D : meta + (size_t)((row - R_META) & 15) * D);
#pragma unroll
        for (int j = 0; j < 8; ++j) v[j] = ((const GAS f32x4*)src)[lane + 64 * j];
    } else {
        v2u w[8];
#pragma unroll
        for (int j = 0; j < 8; ++j) w[j] = ((const GAS v2u*)(h + (size_t)row * D))[lane + 64 * j];
#pragma unroll
        for (int j = 0; j < 8; ++j) v[j] = (f32x4){bflo(w[j].x), bfhi(w[j].x), bflo(w[j].y), bfhi(w[j].y)};
    }
    if (MODE != 1) {
#pragma unroll
        for (int j = 0; j < 8; ++j) {
            const int tu = __builtin_amdgcn_readfirstlane(tmap[(row >> 8) * 8 + j]);
            if (tu >= 0) { const GAS bf16* sp = (const GAS bf16*)slabs + (size_t)tu * TSP * 65536 + (size_t)(row & 255) * 256 + 4 * lane; f32x4 a = (f32x4){0.f, 0.f, 0.f, 0.f};
#pragma unroll
                for (int ks = 0; ks < TSP; ++ks) { const v2u w2 = *(const GAS v2u*)(sp + (size_t)ks * 65536); a += (f32x4){bflo(w2.x), bfhi(w2.x), bflo(w2.y), bfhi(w2.y)}; }
                v[j] += a * scale;
                if (MODE == 0) ((GAS v2u*)(h + (size_t)row * D))[lane + 64 * j] = (v2u){pk2(v[j][0], v[j][1]), pk2(v[j][2], v[j][3])}; }
        }
    }
    return true;
}
template <int MODE>
DI void norm_finish(int row, const f32x4 (&v)[8], GAS bf16* h, const GAS float* gain, GAS float* rs, GAS float* out, int lane) {
    float ss = 0.f;
#pragma unroll
    for (int j = 0; j < 8; ++j) ss += (v[j][0] * v[j][0] + v[j][1] * v[j][1]) + (v[j][2] * v[j][2] + v[j][3] * v[j][3]);
    const float rstd = 1.0f / sqrtf(wave_sum(ss) * (1.0f / D) + EPS);
    if (MODE == 2) {
        GAS float* o = out + (row < R_SAMPLE ? O_YP + (size_t)row * D : O_YS + (size_t)(row - R_SAMPLE) * D);
#pragma unroll
        for (int j = 0; j < 8; ++j) __builtin_nontemporal_store(v[j] * rstd * ((const GAS f32x4*)gain)[lane + 64 * j], (GAS f32x4*)o + lane + 64 * j);
    } else {
        if (lane == 0) rs[row] = rstd;
        if (MODE == 1) {
#pragma unroll
            for (int j = 0; j < 8; ++j) ((GAS v2u*)(h + (size_t)row * D))[lane + 64 * j] = (v2u){pk2(v[j][0], v[j][1]), pk2(v[j][2], v[j][3])};
        }
    }
}
template <int MODE>
DI void norm_phase(const float* xp_, const float* xs_, const float* meta_, bf16* h_, const float* __restrict__ gain_, float* rs_, float* out_, int gw, int NGW, int lane,
                   const float* slabs_, float scale, int Kprev, int G, LAS unsigned char* lds, int tid) {
    const GAS float* xp = (const GAS float*)xp_; const GAS float* xs = (const GAS float*)xs_; const GAS float* meta = (const GAS float*)meta_; GAS bf16* h = (GAS bf16*)h_;
    const GAS float* gain = (const GAS float*)gain_; GAS float* rs = (GAS float*)rs_; GAS float* out = (GAS float*)out_; const GAS float* slabs = (const GAS float*)slabs_;
    LAS int* tmap = (LAS int*)lds;
    if (MODE != 1) {
        for (int i = tid; i < (TP / 256) * 8; i += NWAVES * 64) tmap[i] = -1;
        __syncthreads();
        pg8::TailSplitOrder<TSP> S; S.init(TP, D, Kprev, G, 0);
        const int nt = S.ntail(); const bool split = nt > 0 && nt * TSP <= G && (S.nkt % (2 * TSP)) == 0;
        if (split && tid < nt) { pg8::Unit u; if (S.tail_unit(tid, u)) tmap[u.pm * 8 + u.pn] = tid; }
        __syncthreads();
    }
    for (int row = gw; row < TP; row += NGW) {
        f32x4 va[8];
        if (norm_load<MODE>(row, xp, xs, meta, h, rs, slabs, scale, tmap, lane, va)) norm_finish<MODE>(row, va, h, gain, rs, out, lane);
    }
}

DI void cvt16(const v4u a, const v4u b, float (&f)[16]) {
    f[0] = bflo(a.x); f[1] = bfhi(a.x); f[2] = bflo(a.y); f[3] = bfhi(a.y); f[4] = bflo(a.z); f[5] = bfhi(a.z); f[6] = bflo(a.w); f[7] = bfhi(a.w);
    f[8] = bflo(b.x); f[9] = bfhi(b.x); f[10] = bflo(b.y); f[11] = bfhi(b.y); f[12] = bflo(b.z); f[13] = bfhi(b.z); f[14] = bflo(b.w); f[15] = bfhi(b.w); }
DI void conv_phase(const bf16* proj_, bf16* ymix_, const float* __restrict__ cw_, const float* __restrict__ cg_, const float* __restrict__ sconv_  , float* out_, int l, int gw, int NGW, int lane) {
    const GAS bf16* proj = (const GAS bf16*)proj_; GAS bf16* ymix = (GAS bf16*)ymix_; const GAS float* cw = (const GAS float*)cw_; const GAS float* cg = (const GAS float*)cg_;
    const GAS float* sconv = (const GAS float*)sconv_; GAS float* out = (GAS float*)out_;
    const int c0 = 16 * lane;
    constexpr int NRUN = 4 * 516 + 128 * 2;
    for (int ri = gw; ri < NRUN; ri += NGW) {
        const bool isp = ri < 4 * 516; const int sq = isp ? ri / 516 : (ri - 4 * 516) >> 1, p0 = isp ? 4 * (ri - sq * 516) : 4 * ((ri - 4 * 516) & 1);
#define CONV_ROW(pos) (isp ? row_prompt(sq, (pos)) : R_SAMPLE + sq * 8 + (pos))
        float u1[16], u2[16], t[16];
        if (p0 > 0) { v4u hc[2][2], hh[2][2];
#pragma unroll
            for (int k = 0; k < 2; ++k) { const GAS bf16* pr = proj + (size_t)CONV_ROW(p0 - 2 + k) * NINP + c0;
                hc[k][0] = *(const GAS v4u*)(pr + PC_C); hc[k][1] = *(const GAS v4u*)(pr + PC_C + 8); hh[k][0] = *(const GAS v4u*)(pr + PC_H); hh[k][1] = *(const GAS v4u*)(pr + PC_H + 8); }
            cvt16(hc[0][0], hc[0][1], u2); cvt16(hh[0][0], hh[0][1], t);
#pragma unroll
            for (int i = 0; i < 16; ++i) u2[i] *= t[i];
            cvt16(hc[1][0], hc[1][1], u1); cvt16(hh[1][0], hh[1][1], t);
#pragma unroll
            for (int i = 0; i < 16; ++i) u1[i] *= t[i];
        } else if (!isp) {
#pragma unroll
            for (int i = 0; i < 4; ++i) { const f32x4 s0 = *(const GAS f32x4*)(sconv + ((size_t)sq * 2 + 0) * DCONV + c0 + 4 * i), s1 = *(const GAS f32x4*)(sconv + ((size_t)sq * 2 + 1) * DCONV + c0 + 4 * i);
#pragma unroll
                for (int e = 0; e < 4; ++e) { u2[4 * i + e] = s0[e]; u1[4 * i + e] = s1[e]; } }
        } else {
#pragma unroll
            for (int i = 0; i < 16; ++i) { u2[i] = 0.f; u1[i] = 0.f; }
        }
        v4u nb[2], nc[2], nh[2];
        { const GAS bf16* pr = proj + (size_t)CONV_ROW(p0) * NINP + c0;
          nb[0] = *(const GAS v4u*)(pr + PC_B); nb[1] = *(const GAS v4u*)(pr + PC_B + 8); nc[0] = *(const GAS v4u*)(pr + PC_C); nc[1] = *(const GAS v4u*)(pr + PC_C + 8); nh[0] = *(const GAS v4u*)(pr + PC_H); nh[1] = *(const GAS v4u*)(pr + PC_H + 8); }
#pragma unroll
        for (int k = 0; k < 4; ++k) {
            const int pos = p0 + k, row = CONV_ROW(pos);
            float cb[16], u0[16], y[16], w[16];
            cvt16(nb[0], nb[1], cb); cvt16(nc[0], nc[1], u0); cvt16(nh[0], nh[1], t);
            if (k < 3) { const GAS bf16* pr = proj + (size_t)CONV_ROW(pos + 1) * NINP + c0;
                nb[0] = *(const GAS v4u*)(pr + PC_B); nb[1] = *(const GAS v4u*)(pr + PC_B + 8); nc[0] = *(const GAS v4u*)(pr + PC_C); nc[1] = *(const GAS v4u*)(pr + PC_C + 8); nh[0] = *(const GAS v4u*)(pr + PC_H); nh[1] = *(const GAS v4u*)(pr + PC_H + 8); }
#pragma unroll
            for (int i = 0; i < 16; ++i) u0[i] *= t[i];
            float ss = 0.f;
#pragma unroll
            for (int i = 0; i < 4; ++i) { const f32x4 w0 = *(const GAS f32x4*)(cw + c0 + 4 * i), w1 = *(const GAS f32x4*)(cw + DCONV + c0 + 4 * i), w2 = *(const GAS f32x4*)(cw + 2 * DCONV + c0 + 4 * i);
#pragma unroll
                for (int e = 0; e < 4; ++e) { const int j = 4 * i + e; y[j] = cb[j] * (w0[e] * u2[j] + w1[e] * u1[j] + w2[e] * u0[j]); ss += y[j] * y[j]; } }
            ss += __shfl_xor(ss, 1); ss += __shfl_xor(ss, 2); ss += __shfl_xor(ss, 4);
            const float rs = 1.0f / sqrtf(ss * (1.0f / 128.0f) + EPS);
#pragma unroll
            for (int i = 0; i < 4; ++i) { const f32x4 g4 = *(const GAS f32x4*)(cg + c0 + 4 * i); w[4 * i] = g4[0]; w[4 * i + 1] = g4[1]; w[4 * i + 2] = g4[2]; w[4 * i + 3] = g4[3]; }
            v4u o0, o1;
            o0.x = pk2(y[0] * rs * w[0], y[1] * rs * w[1]); o0.y = pk2(y[2] * rs * w[2], y[3] * rs * w[3]); o0.z = pk2(y[4] * rs * w[4], y[5] * rs * w[5]); o0.w = pk2(y[6] * rs * w[6], y[7] * rs * w[7]);
            o1.x = pk2(y[8] * rs * w[8], y[9] * rs * w[9]); o1.y = pk2(y[10] * rs * w[10], y[11] * rs * w[11]); o1.z = pk2(y[12] * rs * w[12], y[13] * rs * w[13]); o1.w = pk2(y[14] * rs * w[14], y[15] * rs * w[15]);
            GAS bf16* yo = ymix + (size_t)row * D + c0; ((GAS v4u*)yo)[0] = o0; ((GAS v4u*)yo)[1] = o1;
            GAS float* uo = nullptr;
            if (isp) { if (pos >= 2062) uo = out + O_CP + ((size_t)(l * 4 + sq) * 2 + (pos - 2062)) * DCONV; }
            else if (pos >= 6) uo = out + O_CS + ((size_t)(l * 128 + sq) * 2 + (pos - 6)) * DCONV;
            if (uo) {
#pragma unroll
                for (int i = 0; i < 4; ++i) ((GAS f32x4*)(uo + c0))[i] = (f32x4){u0[4 * i], u0[4 * i + 1], u0[4 * i + 2], u0[4 * i + 3]}; }
#pragma unroll
            for (int i = 0; i < 16; ++i) { u2[i] = u1[i]; u1[i] = u0[i]; }
        }
#undef CONV_ROW
    }
}

typedef short bf16x8 __attribute__((ext_vector_type(8)));
DI unsigned pkbf(float lo, float hi) { f32x2 v = {lo, hi}; bf16x2_t r = __builtin_convertvector(v, bf16x2_t); return __builtin_bit_cast(unsigned, r); }
DI bf16x8 mk8(v2u lo, v2u hi) { v4u t = {lo.x, lo.y, hi.x, hi.y}; return __builtin_bit_cast(bf16x8, t); }
DI void tr2(unsigned a0, unsigned a1, v2u& r0, v2u& r1) {
    asm volatile("ds_read_b64_tr_b16 %0, %2\n\tds_read_b64_tr_b16 %1, %3\n\ts_waitcnt lgkmcnt(0)" : "=&v"(r0), "=&v"(r1) : "v"(a0), "v"(a1) : "memory");
}
#define LBAR() do { asm volatile("s_waitcnt lgkmcnt(0)" ::: "memory"); __builtin_amdgcn_s_barrier(); asm volatile("" ::: "memory"); } while (0)
constexpr int GS_QK = 272, GS_V = 528, GS_P = 144, GS_O = 1040;
constexpr int GL_QS = 0, GL_KD = 17408, GL_KL = 34816, GL_V = 52224, GL_PL = 86016, GL_FL = 95232, GL_GT = 99328, GL_EBL = 103424, GL_OL = 0;
DI int chunk_row(bool is_prompt, int bidx, int c, int t) {
    if (is_prompt) { if (c == 0) return t >= 48 ? R_META + 16 * bidx + (t - 48) : -1; return 2048 * bidx + 64 * (c - 1) + t; }
    return t >= 56 ? R_SAMPLE + 8 * bidx + (t - 56) : -1;
}
DI float logsig16(float x) { return (fminf(x, 0.f) - __logf(1.0f + __expf(-fabsf(x)))) * (1.0f / 16.0f); }

#define GLA_LANES() int tid = w * 64 + fresh_lane(); asm volatile("" : "+v"(tid)); const int lane = tid & 63, r = lane & 15, q = lane >> 4, dp = lane, c8 = tid & 31; (void)r; (void)q; (void)dp; (void)c8;
DI void gla_out_stage(LAS unsigned char* lds, const GAS bf16* proj, GAS bf16* ymix, const GAS float* __restrict__ gg, int hd, bool is_prompt, int bidx, int c, const int w) {
    GLA_LANES();
    const f32x4 ggA = *(const GAS f32x4*)(gg + 8 * c8), ggB = *(const GAS f32x4*)(gg + 8 * c8 + 4);
    v4u gw4[4]; int rows[4];
#pragma unroll
    for (int ps = 0; ps < 4; ++ps) { rows[ps] = chunk_row(is_prompt, bidx, c, 16 * ps + (tid >> 5)); const int rc = rows[ps] < 0 ? 0 : rows[ps];
        gw4[ps] = *(const GAS v4u*)(proj + (size_t)rc * NINP + PC_GO + 256 * hd + 8 * c8); }
#pragma unroll
    for (int ps = 0; ps < 4; ++ps) { const int t = 16 * ps + (tid >> 5); const LAS unsigned char* op = lds + GL_OL + t * GS_O + 32 * c8;
        const f32x4 oa = *(const LAS f32x4*)op, ob = *(const LAS f32x4*)(op + 16);
        float ss = (oa[0] * oa[0] + oa[1] * oa[1]) + (oa[2] * oa[2] + oa[3] * oa[3]) + (ob[0] * ob[0] + ob[1] * ob[1]) + (ob[2] * ob[2] + ob[3] * ob[3]);
        ss += __shfl_xor(ss, 1); ss += __shfl_xor(ss, 2); ss += __shfl_xor(ss, 4); ss += __shfl_xor(ss, 8); ss += __shfl_xor(ss, 16);
        const float rs = 1.0f / sqrtf(ss * (1.0f / 256.0f) + EPS);
        if (rows[ps] >= 0) { const v4u g4 = gw4[ps];
            const float gv[8] = {bflo(g4.x), bfhi(g4.x), bflo(g4.y), bfhi(g4.y), bflo(g4.z), bfhi(g4.z), bflo(g4.w), bfhi(g4.w)}; float y[8];
#pragma unroll
            for (int e = 0; e < 4; ++e) { y[e] = oa[e] * rs * ggA[e] * (gv[e] / (1.0f + __expf(-gv[e]))); y[4 + e] = ob[e] * rs * ggB[e] * (gv[4 + e] / (1.0f + __expf(-gv[4 + e]))); }
            *(GAS v4u*)(ymix + (size_t)rows[ps] * D + DCONV + 256 * hd + 8 * c8) = (v4u){pkbf(y[0], y[1]), pkbf(y[2], y[3]), pkbf(y[4], y[5]), pkbf(y[6], y[7])}; } }
}

DI void gla_sample_item(LAS unsigned char* lds, const GAS bf16* proj, GAS bf16* ymix, const GAS float* __restrict__ fw2, const GAS float* __restrict__ fb, const GAS float* __restrict__ gg,
                        int hd, int sb, const GAS float* S_in, GAS float* S_out, const int w) {
    const int lane = fresh_lane();
    LAS float* L_Q = (LAS float*)(lds + 0);
    LAS float* L_K = (LAS float*)(lds + 4096);
    LAS float* L_DEC = (LAS float*)(lds + 8192);
    LAS float* L_V = (LAS float*)(lds + 12288);
    LAS float* L_PART = (LAS float*)(lds + 20480);
    const int row = R_SAMPLE + sb * 8 + w;
    const GAS bf16* pr = proj + (size_t)row * NINP;
    f32x4 S[16];
#pragma unroll
    for (int i = 0; i < 16; ++i) S[i] = __builtin_nontemporal_load((const GAS f32x4*)(S_in + (size_t)(16 * w + i) * GDV) + lane);
    const v2u gw2 = *(const GAS v2u*)(pr + PC_GO + 256 * hd + 4 * lane);
    const f32x4 ggv = ((const GAS f32x4*)gg)[lane];
    {
        const v4u f0 = *(const GAS v4u*)(pr + PC_FL), f1 = *(const GAS v4u*)(pr + PC_FL + 8);
        const float fl[16] = {bflo(f0.x), bfhi(f0.x), bflo(f0.y), bfhi(f0.y), bflo(f0.z), bfhi(f0.z), bflo(f0.w), bfhi(f0.w), bflo(f1.x), bfhi(f1.x), bflo(f1.y), bfhi(f1.y), bflo(f1.z), bfhi(f1.z), bflo(f1.w), bfhi(f1.w)};
        const f32x2 fbv = *(const GAS f32x2*)(fb + 128 * hd + 2 * lane);
        float x0 = fbv[0], x1 = fbv[1];
#pragma unroll
        for (int r = 0; r < 16; ++r) { const f32x2 ww = *(const GAS f32x2*)(fw2 + r * 512 + 128 * hd + 2 * lane); x0 += fl[r] * ww[0]; x1 += fl[r] * ww[1]; }
        const unsigned qw = *(const GAS unsigned*)(pr + PC_Q + 128 * hd + 2 * lane), kw = *(const GAS unsigned*)(pr + PC_K + 128 * hd + 2 * lane);
        const float qs = 0.08838834764831845f;
        *(LAS f32x2*)(L_Q + w * 128 + 2 * lane) = (f32x2){bflo(qw) * qs, bfhi(qw) * qs};
        *(LAS f32x2*)(L_K + w * 128 + 2 * lane) = (f32x2){bflo(kw), bfhi(kw)};
        *(LAS f32x2*)(L_DEC + w * 128 + 2 * lane) = (f32x2){__expf(logsig16(x0)), __expf(logsig16(x1))};
        const v2u vw = *(const GAS v2u*)(pr + PC_V + 256 * hd + 4 * lane);
        *(LAS f32x4*)(L_V + w * 256 + 4 * lane) = (f32x4){bflo(vw.x), bfhi(vw.x), bflo(vw.y), bfhi(vw.y)};
    }
    LBAR();
#pragma unroll 2
    for (int t = 0; t < 8; ++t) {
        const f32x4 vv = *(const LAS f32x4*)(L_V + t * 256 + 4 * lane);
        f32x4 po = (f32x4){0.f, 0.f, 0.f, 0.f};
#pragma unroll
        for (int i4 = 0; i4 < 4; ++i4) {
            const f32x4 dq = *(const LAS f32x4*)(L_DEC + t * 128 + 16 * w + 4 * i4), kq = *(const LAS f32x4*)(L_K + t * 128 + 16 * w + 4 * i4), qq = *(const LAS f32x4*)(L_Q + t * 128 + 16 * w + 4 * i4);
#pragma unroll
            for (int e = 0; e < 4; ++e) { const int i = 4 * i4 + e; S[i] = S[i] * dq[e] + vv * kq[e]; po += S[i] * qq[e]; }
        }
        *(LAS f32x4*)(L_PART + (t * 8 + w) * 256 + 4 * lane) = po;
    }
#pragma unroll
    for (int i = 0; i < 16; ++i) __builtin_nontemporal_store(S[i], (GAS f32x4*)(S_out + (size_t)(16 * w + i) * GDV) + lane);
    LBAR();
    {
        f32x4 o = (f32x4){0.f, 0.f, 0.f, 0.f};
#pragma unroll
        for (int ww = 0; ww < 8; ++ww) o += *(const LAS f32x4*)(L_PART + (w * 8 + ww) * 256 + 4 * lane);
        const float ss = wave_sum((o[0] * o[0] + o[1] * o[1]) + (o[2] * o[2] + o[3] * o[3]));
        const float rs = 1.0f / sqrtf(ss * (1.0f / 256.0f) + EPS);
        const float gv[4] = {bflo(gw2.x), bfhi(gw2.x), bflo(gw2.y), bfhi(gw2.y)}; float y[4];
#pragma unroll
        for (int e = 0; e < 4; ++e) y[e] = o[e] * rs * ggv[e] * (gv[e] / (1.0f + __expf(-gv[e])));
        *(GAS v2u*)(ymix + (size_t)row * D + DCONV + 256 * hd + 4 * lane) = (v2u){pkbf(y[0], y[1]), pkbf(y[2], y[3])};
    }
    LBAR();
}

DI void gla_item_mfma(LAS unsigned char* lds, const GAS bf16* proj, GAS bf16* ymix, const GAS float* __restrict__ fw2, const GAS float* __restrict__ fb, const GAS float* __restrict__ gg,
                      int hd, bool is_prompt, int bidx, int c0, const GAS float* S_in, GAS float* S_out, const int w,
                      GAS bf16* gqs, GAS bf16* gpl, GAS float* gebl, GAS float* gu) {
    const int tg = w;
#define GLA_LOAD_QK(c, DP) do { \
        _Pragma("unroll") for (int i = 0; i < 8; ++i) { const int row_ = chunk_row(is_prompt, bidx, (c), 8 * tg + i); const int rc_ = row_ < 0 ? 0 : row_; \
            const GAS bf16* p_ = proj + (size_t)rc_ * NINP + 128 * hd + 2 * (DP); const unsigned qv_ = *(const GAS unsigned*)(p_ + PC_Q), kv_ = *(const GAS unsigned*)(p_ + PC_K); qw[i] = row_ < 0 ? 0u : qv_; kw[i] = row_ < 0 ? 0u : kv_; } \
    } while (0)
#define GLA_LOAD_V(c) do { \
        _Pragma("unroll") for (int i = 0; i < 4; ++i) { const int row_ = chunk_row(is_prompt, bidx, (c), (tid >> 5) + 16 * i); const int rc_ = row_ < 0 ? 0 : row_; \
            const v4u vv_ = *(const GAS v4u*)(proj + (size_t)rc_ * NINP + PC_V + 256 * hd + 8 * c8); vr[i] = row_ < 0 ? (v4u){0u, 0u, 0u, 0u} : vv_; } \
        { const int row_ = chunk_row(is_prompt, bidx, (c), (tid >> 1) & 63); const int rc_ = row_ < 0 ? 0 : row_; const v4u ff_ = *(const GAS v4u*)(proj + (size_t)rc_ * NINP + PC_FL + 8 * (tid & 1)); flr = row_ < 0 ? (v4u){0u, 0u, 0u, 0u} : ff_; } \
    } while (0)
    {
        const int c = c0;
        const int tmin = is_prompt ? (c == 0 ? 48 : 0) : 56;
        {
            GLA_LANES();
            v4u vr[4]; v4u flr;
            GLA_LOAD_V(c);
#pragma unroll
            for (int i = 0; i < 4; ++i) *(LAS v4u*)(lds + GL_V + ((tid >> 5) + 16 * i) * GS_V + 16 * c8) = vr[i];
            if (tid < 128) { LAS float* f = (LAS float*)(lds + GL_FL) + (tid >> 1) * 16 + 8 * (tid & 1);
                *(LAS f32x4*)f = (f32x4){bflo(flr.x), bfhi(flr.x), bflo(flr.y), bfhi(flr.y)}; *(LAS f32x4*)(f + 4) = (f32x4){bflo(flr.z), bfhi(flr.z), bflo(flr.w), bfhi(flr.w)}; }
        }
        LBAR();
        {
            const int dpa = fresh_lane();
            const f32x2 fbv = *(const GAS f32x2*)(fb + 128 * hd + 2 * dpa);
            unsigned qw[8], kw[8];
            GLA_LOAD_QK(c, dpa);
            float c0[8], c1[8]; float run0 = 0.f, run1 = 0.f;
#pragma unroll
            for (int i = 0; i < 8; ++i) { c0[i] = fbv[0]; c1[i] = fbv[1]; }
#pragma unroll
            for (int j = 0; j < 4; ++j) { f32x2 fwj[4];
#pragma unroll
                for (int e = 0; e < 4; ++e) fwj[e] = *(const GAS f32x2*)(fw2 + (4 * j + e) * 512 + 128 * hd + 2 * dpa);
#pragma unroll
                for (int i = 0; i < 8; ++i) { const f32x4 f = ((const LAS f32x4*)(lds + GL_FL))[(8 * tg + i) * 4 + j];
#pragma unroll
                    for (int e = 0; e < 4; ++e) { c0[i] += f[e] * fwj[e][0]; c1[i] += f[e] * fwj[e][1]; } }
                __builtin_amdgcn_sched_barrier(0); }
#pragma unroll
            for (int i = 0; i < 8; ++i) { const bool valid = (8 * tg + i) >= tmin;
                run0 += valid ? logsig16(c0[i]) : 0.f; run1 += valid ? logsig16(c1[i]) : 0.f; c0[i] = run0; c1[i] = run1; if (i & 1) __builtin_amdgcn_sched_barrier(0); }
            { const int dp2 = fresh_lane(); *(LAS f32x2*)(lds + GL_GT + (tg * 128 + 2 * dp2) * 4) = (f32x2){run0, run1}; }
            LBAR();
            const int dp = fresh_lane();
            float off0 = 0.f, off1 = 0.f, tot0 = 0.f, tot1 = 0.f;
#pragma unroll
            for (int g8 = 0; g8 < 8; ++g8) { const f32x2 v = *(const LAS f32x2*)(lds + GL_GT + (g8 * 128 + 2 * dp) * 4); tot0 += v[0]; tot1 += v[1]; if (g8 < tg) { off0 += v[0]; off1 += v[1]; } }
#pragma unroll
            for (int i = 0; i < 8; ++i) { const int t = 8 * tg + i; const float b0 = off0 + c0[i], b1 = off1 + c1[i];
                const float eb0 = __expf(b0), eb1 = __expf(b1), en0 = __expf(-b0), en1 = __expf(-b1), el0 = __expf(tot0 - b0), el1 = __expf(tot1 - b1);
                const float q0 = bflo(qw[i]) * 0.08838834764831845f, q1 = bfhi(qw[i]) * 0.08838834764831845f, k0 = bflo(kw[i]), k1 = bfhi(kw[i]);
                *(LAS unsigned*)(lds + GL_QS + t * GS_QK + 4 * dp) = pkbf(q0 * eb0, q1 * eb1);
                *(LAS unsigned*)(lds + GL_KD + t * GS_QK + 4 * dp) = pkbf(k0 * en0, k1 * en1);
                *(LAS unsigned*)(lds + GL_KL + t * GS_QK + 4 * dp) = pkbf(k0 * el0, k1 * el1); if (i & 1) __builtin_amdgcn_sched_barrier(0); }
            if (tg == 0) *(LAS f32x2*)(lds + GL_EBL + 8 * dp) = (f32x2){__expf(tot0), __expf(tot1)};
        }
        LBAR();
        {
            GLA_LANES();
#pragma unroll
            for (int j2 = 0; j2 < 2; ++j2) { const int idx = 2 * w + j2, st = idx >> 2, tt = idx & 3;
                f32x4 acc = (f32x4){0.f, 0.f, 0.f, 0.f};
                if (st <= tt) {
#pragma unroll
                    for (int ks = 0; ks < 4; ++ks) { const bf16x8 a = *(const LAS bf16x8*)(lds + GL_KD + (16 * st + r) * GS_QK + (32 * ks + 8 * q) * 2), b = *(const LAS bf16x8*)(lds + GL_QS + (16 * tt + r) * GS_QK + (32 * ks + 8 * q) * 2);
                        acc = __builtin_amdgcn_mfma_f32_16x16x32_bf16(a, b, acc, 0, 0, 0); }
                }
                const int tq = 16 * tt + r, s0 = 16 * st + 4 * q;
                const float p0 = (s0 + 0 <= tq) ? acc[0] : 0.f, p1 = (s0 + 1 <= tq) ? acc[1] : 0.f, p2 = (s0 + 2 <= tq) ? acc[2] : 0.f, p3 = (s0 + 3 <= tq) ? acc[3] : 0.f;
                *(LAS v2u*)(lds + GL_PL + tq * GS_P + s0 * 2) = (v2u){pkbf(p0, p1), pkbf(p2, p3)}; }
        }
        LBAR();
        if (is_prompt) {
            GLA_LANES();
            const unsigned lbase = (unsigned)(uintptr_t)lds;
            bf16x8 Vf[2][2];
#pragma unroll
            for (int ks = 0; ks < 2; ++ks)
#pragma unroll
                for (int vt = 0; vt < 2; ++vt) { const unsigned a0 = lbase + GL_V + (32 * ks + 8 * q + (r >> 2)) * GS_V + (32 * w + 16 * vt + 4 * (r & 3)) * 2; v2u lo, hi; tr2(a0, a0 + 4 * GS_V, lo, hi); Vf[ks][vt] = mk8(lo, hi); }
#pragma unroll
            for (int dt = 0; dt < 8; ++dt) { f32x4 C0 = (f32x4){0.f, 0.f, 0.f, 0.f}, C1 = (f32x4){0.f, 0.f, 0.f, 0.f};
#pragma unroll
                for (int ks = 0; ks < 2; ++ks) { const unsigned a0 = lbase + GL_KL + (32 * ks + 8 * q + (r >> 2)) * GS_QK + (16 * dt + 4 * (r & 3)) * 2; v2u lo, hi; tr2(a0, a0 + 4 * GS_QK, lo, hi); const bf16x8 kl = mk8(lo, hi);
                    C0 = __builtin_amdgcn_mfma_f32_16x16x32_bf16(Vf[ks][0], kl, C0, 0, 0, 0); C1 = __builtin_amdgcn_mfma_f32_16x16x32_bf16(Vf[ks][1], kl, C1, 0, 0, 0); }
                GAS bf16* up = (GAS bf16*)gu + (size_t)(16 * dt + r) * GDV + 32 * w + 4 * q; *(GAS v2u*)up = (v2u){pkbf(C0[0], C0[1]), pkbf(C0[2], C0[3])}; *(GAS v2u*)(up + 16) = (v2u){pkbf(C1[0], C1[1]), pkbf(C1[2], C1[3])}; __builtin_amdgcn_sched_barrier(0); }
            { const int row = tid >> 3, ch = tid & 7;
              const v4u a = *(const LAS v4u*)(lds + GL_QS + row * GS_QK + 32 * ch), b2 = *(const LAS v4u*)(lds + GL_QS + row * GS_QK + 32 * ch + 16);
              *(GAS v4u*)(gqs + row * 128 + 16 * ch) = a; *(GAS v4u*)(gqs + row * 128 + 16 * ch + 8) = b2;
              *(GAS v4u*)(gpl + row * 64 + 8 * ch) = *(const LAS v4u*)(lds + GL_PL + row * GS_P + 16 * ch);
              if (tid < 128) gebl[tid] = *(const LAS float*)(lds + GL_EBL + 4 * tid); }
            LBAR();
            return;
        }
        f32x4 O[4][2]; f32x4 Sacc[8][2];
        {
            GLA_LANES();
            { const GAS float* sp = S_in + (size_t)(4 * q) * GDV + 32 * w + r;
#pragma unroll
              for (int dt = 0; dt < 8; ++dt)
#pragma unroll
                  for (int vt = 0; vt < 2; ++vt)
#pragma unroll
                      for (int i = 0; i < 4; ++i) Sacc[dt][vt][i] = sp[(16 * dt + i) * GDV + 16 * vt]; }
            const unsigned lbase = (unsigned)(uintptr_t)lds;
#pragma unroll
            for (int tt = 0; tt < 4; ++tt) { O[tt][0] = (f32x4){0.f, 0.f, 0.f, 0.f}; O[tt][1] = (f32x4){0.f, 0.f, 0.f, 0.f}; }
#pragma unroll
            for (int ks = 0; ks < 4; ++ks) {
                bf16x8 Sb[2];
#pragma unroll
                for (int vt = 0; vt < 2; ++vt) { const f32x4 lo = Sacc[2 * ks][vt], hi = Sacc[2 * ks + 1][vt]; Sb[vt] = __builtin_bit_cast(bf16x8, (v4u){pkbf(lo[0], lo[1]), pkbf(lo[2], lo[3]), pkbf(hi[0], hi[1]), pkbf(hi[2], hi[3])}); }
#pragma unroll
                for (int tt = 0; tt < 4; ++tt) { const LAS unsigned char* qp = lds + GL_QS + (16 * tt + r) * GS_QK + (32 * ks + 4 * q) * 2;
                    const bf16x8 a = mk8(*(const LAS v2u*)qp, *(const LAS v2u*)(qp + 32));
                    O[tt][0] = __builtin_amdgcn_mfma_f32_16x16x32_bf16(a, Sb[0], O[tt][0], 0, 0, 0); O[tt][1] = __builtin_amdgcn_mfma_f32_16x16x32_bf16(a, Sb[1], O[tt][1], 0, 0, 0); }
                __builtin_amdgcn_sched_barrier(0);
            }
            bf16x8 Vf[2][2];
#pragma unroll
            for (int ks = 0; ks < 2; ++ks)
#pragma unroll
                for (int vt = 0; vt < 2; ++vt) { const unsigned a0 = lbase + GL_V + (32 * ks + 8 * q + (r >> 2)) * GS_V + (32 * w + 16 * vt + 4 * (r & 3)) * 2; v2u lo, hi; tr2(a0, a0 + 4 * GS_V, lo, hi); Vf[ks][vt] = mk8(lo, hi); }
#pragma unroll
            for (int ks = 0; ks < 2; ++ks)
#pragma unroll
                for (int tt = 0; tt < 4; ++tt) { const bf16x8 a = *(const LAS bf16x8*)(lds + GL_PL + (16 * tt + r) * GS_P + (32 * ks + 8 * q) * 2);
                    O[tt][0] = __builtin_amdgcn_mfma_f32_16x16x32_bf16(a, Vf[ks][0], O[tt][0], 0, 0, 0); O[tt][1] = __builtin_amdgcn_mfma_f32_16x16x32_bf16(a, Vf[ks][1], O[tt][1], 0, 0, 0); }
            __builtin_amdgcn_sched_barrier(0);
#pragma unroll
            for (int dt = 0; dt < 8; ++dt) { const f32x4 e4 = *(const LAS f32x4*)(lds + GL_EBL + (16 * dt + 4 * q) * 4);
                f32x4 C0 = Sacc[dt][0] * e4, C1 = Sacc[dt][1] * e4;
#pragma unroll
                for (int ks = 0; ks < 2; ++ks) { const unsigned a0 = lbase + GL_KL + (32 * ks + 8 * q + (r >> 2)) * GS_QK + (16 * dt + 4 * (r & 3)) * 2; v2u lo, hi; tr2(a0, a0 + 4 * GS_QK, lo, hi); const bf16x8 a = mk8(lo, hi);
                    C0 = __builtin_amdgcn_mfma_f32_16x16x32_bf16(a, Vf[ks][0], C0, 0, 0, 0); C1 = __builtin_amdgcn_mfma_f32_16x16x32_bf16(a, Vf[ks][1], C1, 0, 0, 0); }
                GAS float* so = S_out + (size_t)(16 * dt + 4 * q) * GDV + 32 * w + r;
#pragma unroll
                for (int i = 0; i < 4; ++i) { so[i * GDV] = C0[i]; so[i * GDV + 16] = C1[i]; }
                __builtin_amdgcn_sched_barrier(0); }
        }
        LBAR();
        {   GLA_LANES();
#pragma unroll
            for (int tt = 0; tt < 4; ++tt)
#pragma unroll
                for (int vt = 0; vt < 2; ++vt)
#pragma unroll
                    for (int i = 0; i < 4; ++i) *(LAS float*)(lds + GL_OL + (16 * tt + 4 * q + i) * GS_O + (32 * w + 16 * vt + r) * 4) = O[tt][vt][i];
        }
        LBAR();
        gla_out_stage(lds, proj, ymix, gg, hd, is_prompt, bidx, c, w);
        LBAR();
    }
#undef GLA_LOAD_QK
#undef GLA_LOAD_V
}

DI void gla_scan_phase(const GAS float* gu, const GAS float* gebl, GAS bf16* gs, GAS float* out_state, int gtid, int nthreads) {
    for (int e = gtid; e < 16 * 8192; e += nthreads) {
        const int bh = e >> 13, rem = e & 8191, d = rem >> 6, v = (rem & 63) * 4;
        f32x4 S = (f32x4){0.f, 0.f, 0.f, 0.f};
#pragma nounroll
        for (int c3 = 0; c3 < 33; c3 += 11) {
            f32x4 u[11]; float eb[11];
#pragma unroll
            for (int j = 0; j < 11; ++j) { const size_t idx = (size_t)bh * 33 + c3 + j; const v2u w2 = *(const GAS v2u*)((const GAS bf16*)gu + (idx * GDK + d) * GDV + v); u[j] = (f32x4){bflo(w2.x), bfhi(w2.x), bflo(w2.y), bfhi(w2.y)}; eb[j] = gebl[idx * GDK + d]; }
#pragma unroll
            for (int j = 0; j < 11; ++j) { const size_t idx = (size_t)bh * 33 + c3 + j;
                *(GAS v2u*)(gs + (idx * GDK + d) * GDV + v) = (v2u){pkbf(S[0], S[1]), pkbf(S[2], S[3])};
                S = S * eb[j] + u[j]; }
        }
        *(GAS f32x4*)(out_state + ((size_t)bh * GDK + d) * GDV + v) = S;
    }
}

constexpr int CS_S = 0, CS_QS = 67584, CS_PL = 84992, CS_V = 94208;
DI void gla_passC_item(LAS unsigned char* lds, const GAS bf16* proj, GAS bf16* ymix, const GAS float* __restrict__ gg, int hd, int bidx, int c, const int w,
                       const GAS bf16* gqs, const GAS bf16* gpl, const GAS bf16* gs) {
    {   GLA_LANES();
        v4u sr[8], qr[2], pr, vr[4];
        if (c != 0) {
#pragma unroll
            for (int i = 0; i < 8; ++i) sr[i] = *(const GAS v4u*)(gs + (size_t)((tid >> 5) + 16 * i) * GDV + 8 * c8);
        }
        { const int row = tid >> 3, ch = tid & 7; qr[0] = *(const GAS v4u*)(gqs + row * 128 + 16 * ch); qr[1] = *(const GAS v4u*)(gqs + row * 128 + 16 * ch + 8); pr = *(const GAS v4u*)(gpl + row * 64 + 8 * ch); }
#pragma unroll
        for (int i = 0; i < 4; ++i) { const int row_ = chunk_row(true, bidx, c, (tid >> 5) + 16 * i); const int rc_ = row_ < 0 ? 0 : row_;
            const v4u vv_ = *(const GAS v4u*)(proj + (size_t)rc_ * NINP + PC_V + 256 * hd + 8 * c8); vr[i] = row_ < 0 ? (v4u){0u, 0u, 0u, 0u} : vv_; }
        if (c != 0) {
#pragma unroll
            for (int i = 0; i < 8; ++i) *(LAS v4u*)(lds + CS_S + ((tid >> 5) + 16 * i) * GS_V + 16 * c8) = sr[i];
        }
        { const int row = tid >> 3, ch = tid & 7; *(LAS v4u*)(lds + CS_QS + row * GS_QK + 32 * ch) = qr[0]; *(LAS v4u*)(lds + CS_QS + row * GS_QK + 32 * ch + 16) = qr[1]; *(LAS v4u*)(lds + CS_PL + row * GS_P + 16 * ch) = pr; }
#pragma unroll
        for (int i = 0; i < 4; ++i) *(LAS v4u*)(lds + CS_V + ((tid >> 5) + 16 * i) * GS_V + 16 * c8) = vr[i];
    }
    LBAR();
    f32x4 O[4][2];
    {   GLA_LANES();
        const unsigned lbase = (unsigned)(uintptr_t)lds;
#pragma unroll
        for (int tt = 0; tt < 4; ++tt) { O[tt][0] = (f32x4){0.f, 0.f, 0.f, 0.f}; O[tt][1] = (f32x4){0.f, 0.f, 0.f, 0.f}; }
        if (c != 0) {
#pragma unroll
        for (int ks = 0; ks < 4; ++ks) {
            bf16x8 Sf[2];
#pragma unroll
            for (int vt = 0; vt < 2; ++vt) { const unsigned a0 = lbase + CS_S + (32 * ks + 8 * q + (r >> 2)) * GS_V + (32 * w + 16 * vt + 4 * (r & 3)) * 2; v2u lo, hi; tr2(a0, a0 + 4 * GS_V, lo, hi); Sf[vt] = mk8(lo, hi); }
#pragma unroll
            for (int tt = 0; tt < 4; ++tt) { const bf16x8 a = *(const LAS bf16x8*)(lds + CS_QS + (16 * tt + r) * GS_QK + (32 * ks + 8 * q) * 2);
                O[tt][0] = __builtin_amdgcn_mfma_f32_16x16x32_bf16(a, Sf[0], O[tt][0], 0, 0, 0); O[tt][1] = __builtin_amdgcn_mfma_f32_16x16x32_bf16(a, Sf[1], O[tt][1], 0, 0, 0); }
            __builtin_amdgcn_sched_barrier(0);
        }
        }
#pragma unroll
        for (int ks = 0; ks < 2; ++ks) {
            bf16x8 Vf[2];
#pragma unroll
            for (int vt = 0; vt < 2; ++vt) { const unsigned a0 = lbase + CS_V + (32 * ks + 8 * q + (r >> 2)) * GS_V + (32 * w + 16 * vt + 4 * (r & 3)) * 2; v2u lo, hi; tr2(a0, a0 + 4 * GS_V, lo, hi); Vf[vt] = mk8(lo, hi); }
#pragma unroll
            for (int tt = 0; tt < 4; ++tt) { const bf16x8 a = *(const LAS bf16x8*)(lds + CS_PL + (16 * tt + r) * GS_P + (32 * ks + 8 * q) * 2);
                O[tt][0] = __builtin_amdgcn_mfma_f32_16x16x32_bf16(a, Vf[0], O[tt][0], 0, 0, 0); O[tt][1] = __builtin_amdgcn_mfma_f32_16x16x32_bf16(a, Vf[1], O[tt][1], 0, 0, 0); }
            __builtin_amdgcn_sched_barrier(0);
        }
    }
    LBAR();
    {   GLA_LANES();
#pragma unroll
        for (int tt = 0; tt < 4; ++tt)
#pragma unroll
            for (int vt = 0; vt < 2; ++vt)
#pragma unroll
                for (int i = 0; i < 4; ++i) *(LAS float*)(lds + GL_OL + (16 * tt + 4 * q + i) * GS_O + (32 * w + 16 * vt + r) * 4) = O[tt][vt][i];
    }
    LBAR();
    gla_out_stage(lds, proj, ymix, gg, hd, true, bidx, c, w);
    LBAR();
}
#undef GLA_LANES

struct Args { const float* in[20]; float* out; unsigned char* ws; int ph_lo, ph_hi; };
constexpr int N_PHASES = 1 + 12 * DEPTH;

__global__ void __launch_bounds__(NWAVES * 64, 2) mk_fwd(Args args) {
    extern __shared__ __attribute__((aligned(16))) unsigned char lds_raw[];
    LAS unsigned char* lds = (LAS unsigned char*)lds_raw;
    volatile LAS unsigned* MISC = (volatile LAS unsigned*)(lds + MISC_OFF);
    const int tid = threadIdx.x, lane = tid & 63, wave = __builtin_amdgcn_readfirstlane(tid >> 6);
    const int G = gridDim.x, bx = blockIdx.x;
    const int vcu = (G % 8 == 0) ? (bx % 8) * (G / 8) + bx / 8 : bx;
    const int gw = vcu * NWAVES + wave, NGW = G * NWAVES;
    unsigned char* ws = args.ws;
    unsigned* ctl = (unsigned*)(ws + WS_CTL);
    bf16* hbuf = (bf16*)(ws + WS_H); float* xn = (float*)(ws + WS_XN); bf16* act = (bf16*)(ws + WS_ACT); bf16* proj = (bf16*)(ws + WS_PROJ); bf16* ymix = (bf16*)(ws + WS_YMIX);
    if (tid < 32) MISC[tid] = 0u;
    __syncthreads();
    XcdBarrier bar; bar.bar = ctl + CW_BAR; bar.x = 0; bar.st = nullptr;
    if (MK_N_LAUNCHES == 1) bar = xcd_barrier_post(ctl + CW_BAR, MISC + 8, wave);
    const int lo = args.ph_lo, hi = args.ph_hi;
#define IN(k) (lo <= (k) && (k) < hi)
#define SEAM(k) do { if (MK_N_LAUNCHES == 1 && IN((k) + 1)) xcd_barrier(bar, wave); } while (0)

#define CONVERT_RANGE(ib, ie, widx, wstride) convert_range(args.in[6], args.in[7], args.in[9], args.in[15], args.in[17], args.in[18], args.in[5], args.in[8], args.in[16], args.ws + WS_W, (ib), (ie), (widx), (wstride), (LAS float*)(lds + wave * 16640), fresh_lane())
#define CONVERT_IN_TAIL(nbusy, ib, ie) do { int fi_ = (nbusy), ni_ = G_ - fi_; if (ni_ <= 0) { fi_ = 0; ni_ = G_; } \
        const int gb_ = I_GU + l_p * I_LAYER + (ib), ge_ = (I_GU + l_p * I_LAYER + (ie)) < DEPTH * I_LAYER ? (I_GU + l_p * I_LAYER + (ie)) : DEPTH * I_LAYER; \
        if (bx_ >= fi_ && gb_ < ge_) CONVERT_RANGE(gb_, ge_, (bx_ - fi_) * NWAVES + wave, ni_ * NWAVES); } while (0)
    constexpr int CV0 = 0, CV1 = 2820, CV2 = 6900, CV3 = 12700, CV4 = 14240, CV5 = 16940, CV6 = I_LAYER;
    static_assert(I_GU + CV1 >= I_GU + I_DN && I_GU + CV2 >= I_GU + I_DN + I_IN && I_GU + CV3 >= I_GU + I_DN + I_IN + I_OUT && I_GU + CV4 >= 2 * I_GU + I_DN + I_IN + I_OUT && I_GU + CV5 >= I_LAYER, "conversion runs ahead of consumption");
    if (IN(0)) {
        CONVERT_RANGE(0, I_GU, gw, NGW);
        for (int i = gw * 64 + lane; i < DEPTH * (NINP - NIN) * (D / 8); i += NGW * 64) { const int l = i / ((NINP - NIN) * (D / 8)), r = i % ((NINP - NIN) * (D / 8));
            ((v4u*)(ws + WS_W + (size_t)l * W_LAYER + WO_IN + (size_t)NIN * D * 2))[r] = (v4u){0u, 0u, 0u, 0u}; }
        norm_phase<1>(args.in[0], args.in[1], args.in[4], hbuf, args.in[5], xn, nullptr, gw, NGW, lane, nullptr, 0.f, D, G, lds, tid);
        SEAM(0);
    }

#define PH_LOCALS() int tid_p = wave * 64 + fresh_lane(); asm volatile("" : "+v"(tid_p)); const int lane_p = tid_p & 63; int gw_p = gw, ngw_p = NGW, G_ = gridDim.x, bx_ = blockIdx.x, vcu_p = vcu, l_p = l; \
        unsigned char* ws_p = ws; asm volatile("" : "+s"(gw_p), "+s"(ngw_p), "+s"(G_), "+s"(bx_), "+s"(vcu_p), "+s"(l_p), "+s"(ws_p)); \
        unsigned char* wl = ws_p + WS_W + (size_t)l_p * W_LAYER; unsigned* ctl_p = (unsigned*)(ws_p + WS_CTL); bf16* hbuf_p = (bf16*)(ws_p + WS_H); float* xn_p = (float*)(ws_p + WS_XN); bf16* act_p = (bf16*)(ws_p + WS_ACT); bf16* proj_p = (bf16*)(ws_p + WS_PROJ); bf16* ymix_p = (bf16*)(ws_p + WS_YMIX); \
        (void)ctl_p; (void)lane_p; (void)gw_p; (void)ngw_p; (void)G_; (void)bx_; (void)vcu_p; (void)wl; (void)hbuf_p; (void)xn_p; (void)act_p; (void)proj_p; (void)ymix_p;
#pragma nounroll
    for (int l = 0; l < DEPTH; ++l) {
        const int pb = 1 + 12 * l;
        if (IN(pb + 0)) { PH_LOCALS();
            pg8::Gemm g{hbuf_p, (const bf16*)(wl + WO_GU1), TP, NGU, D}; pg8::PairSplitOrder S; S.init(TP, NGU, D, G_, bx_);
            pg8::EpiSwiGLU E{act_p, FF, xn_p, (float*)(ws_p + WS_SLAB), ctl_p + CW_GCNT + (2 * l_p + 0) * GCNT_STRIDE};
            pg8::gemm_phase<pg8::EpiSwiGLU, pg8::PairSplitOrder, true, true>(lds, g, S, E, wave);
            CONVERT_IN_TAIL(S.nbusy_last(), CV0, CV1);
            SEAM(pb + 0);
        }
        if (IN(pb + 1)) { PH_LOCALS();
            pg8::Gemm g{act_p, (const bf16*)(wl + WO_DN1), TP, D, FF}; pg8::TailSplitOrder<TSP> S; S.init(TP, D, FF, G_, bx_);
            pg8::EpiResid E{hbuf_p, D, 0.5f, (float*)(ws_p + WS_SLAB)};
            pg8::gemm_phase<pg8::EpiResid, pg8::TailSplitOrder<TSP>, true, true>(lds, g, S, E, wave);
            CONVERT_IN_TAIL(S.ntail() * TSP, CV1, CV2);
            SEAM(pb + 1);
        }
        if (IN(pb + 2)) { PH_LOCALS(); norm_phase<0>(nullptr, nullptr, nullptr, hbuf_p, args.in[8] + (size_t)l_p * D, xn_p, nullptr, gw_p, ngw_p, lane_p, (const float*)(ws_p + WS_SLAB), 0.5f, FF, G_, lds, tid_p); SEAM(pb + 2); }
        if (IN(pb + 3)) { PH_LOCALS();
            pg8::Gemm g{hbuf_p, (const bf16*)(wl + WO_IN), TP, NINP, D}; pg8::StaticOrder S; S.init(TP, NINP, D, G_, bx_);
            pg8::EpiBf16 E{proj_p, NINP, xn_p};
            pg8::gemm_phase<pg8::EpiBf16, pg8::StaticOrder, true, true>(lds, g, S, E, wave);
            CONVERT_IN_TAIL(S.nwg % G_, CV2, CV3);
            SEAM(pb + 3);
        }
        if (IN(pb + 4)) { PH_LOCALS();
            if (G_ <= 32) conv_phase(proj_p, ymix_p, args.in[10] + (size_t)l_p * 3 * DCONV, args.in[11] + (size_t)l_p * DCONV, args.in[2] + (size_t)l_p * 128 * 2 * DCONV, args.out, l_p, gw_p, ngw_p, lane_p);
            else if (vcu_p >= 16) conv_phase(proj_p, ymix_p, args.in[10] + (size_t)l_p * 3 * DCONV, args.in[11] + (size_t)l_p * DCONV, args.in[2] + (size_t)l_p * 128 * 2 * DCONV, args.out, l_p, gw_p - 16 * NWAVES, ngw_p - 16 * NWAVES, lane_p);
            const GAS float* fw2 = (const GAS float*)args.in[12] + (size_t)l_p * GRANK * 512; const GAS float* fb = (const GAS float*)args.in[13] + (size_t)l_p * 512; const GAS float* gg = (const GAS float*)args.in[14] + (size_t)l_p * GDV;
            for (int it = vcu_p; it < 1040; it += G_) {
                const bool isp = it >= 512; const int j = isp ? it - 512 : it;
                const int bh = isp ? j / 33 : j, c = isp ? j - bh * 33 : 0, bi = bh >> 2, hd = bh & 3;
                if (!isp) gla_sample_item(lds, (const GAS bf16*)proj_p, (GAS bf16*)ymix_p, fw2, fb, gg, hd, bi, (const GAS float*)args.in[3] + ((size_t)l_p * 512 + bh) * GDK * GDV, (GAS float*)args.out + O_GS + ((size_t)l_p * 512 + bh) * GDK * GDV, wave);
                else gla_item_mfma(lds, (const GAS bf16*)proj_p, (GAS bf16*)ymix_p, fw2, fb, gg, hd, true, bi, c, nullptr, nullptr, wave,
                              (GAS bf16*)(ws_p + WS_GQS) + (size_t)j * 8192, (GAS bf16*)(ws_p + WS_GPL) + (size_t)j * 4096, (GAS float*)(ws_p + WS_GEBL) + (size_t)j * 128, (GAS float*)((GAS bf16*)(ws_p + WS_GU) + (size_t)j * 32768));
            }
            SEAM(pb + 4);
        }
        if (IN(pb + 5)) { PH_LOCALS();
            gla_scan_phase((const GAS float*)(ws_p + WS_GU), (const GAS float*)(ws_p + WS_GEBL), (GAS bf16*)(ws_p + WS_GS), (GAS float*)args.out + O_GP + (size_t)l_p * 16 * GDK * GDV, vcu_p * (NWAVES * 64) + tid_p, G_ * (NWAVES * 64));
            SEAM(pb + 5);
        }
        if (IN(pb + 6)) { PH_LOCALS();
            const GAS float* gg = (const GAS float*)args.in[14] + (size_t)l_p * GDV;
            for (int it = vcu_p; it < 528; it += G_) { const int bh = it < 512 ? (it >> 5) : it - 512, c = it < 512 ? 1 + (it & 31) : 0, j = bh * 33 + c;
                gla_passC_item(lds, (const GAS bf16*)proj_p, (GAS bf16*)ymix_p, gg, bh & 3, bh >> 2, c, wave,
                               (const GAS bf16*)(ws_p + WS_GQS) + (size_t)j * 8192, (const GAS bf16*)(ws_p + WS_GPL) + (size_t)j * 4096, (const GAS bf16*)(ws_p + WS_GS) + (size_t)j * 32768); }
            SEAM(pb + 6);
        }
        if (IN(pb + 7)) { PH_LOCALS();
            pg8::Gemm g{ymix_p, (const bf16*)(wl + WO_OUT), TP, D, D}; pg8::TailSplitOrder<TSP> S; S.init(TP, D, D, G_, bx_);
            pg8::EpiResid E{hbuf_p, D, 1.0f, (float*)(ws_p + WS_SLAB)};
            pg8::gemm_phase<pg8::EpiResid, pg8::TailSplitOrder<TSP>, true, true>(lds, g, S, E, wave);
            CONVERT_IN_TAIL(S.ntail() * TSP, CV3, CV4);
            SEAM(pb + 7);
        }
        if (IN(pb + 8)) { PH_LOCALS(); norm_phase<0>(nullptr, nullptr, nullptr, hbuf_p, args.in[16] + (size_t)l_p * D, xn_p, nullptr, gw_p, ngw_p, lane_p, (const float*)(ws_p + WS_SLAB), 1.0f, D, G_, lds, tid_p); SEAM(pb + 8); }
        if (IN(pb + 9)) { PH_LOCALS();
            pg8::Gemm g{hbuf_p, (const bf16*)(wl + WO_GU2), TP, NGU, D}; pg8::PairSplitOrder S; S.init(TP, NGU, D, G_, bx_);
            pg8::EpiSwiGLU E{act_p, FF, xn_p, (float*)(ws_p + WS_SLAB), ctl_p + CW_GCNT + (2 * l_p + 1) * GCNT_STRIDE};
            pg8::gemm_phase<pg8::EpiSwiGLU, pg8::PairSplitOrder, true, true>(lds, g, S, E, wave);
            CONVERT_IN_TAIL(S.nbusy_last(), CV4, CV5);
            SEAM(pb + 9);
        }
        if (IN(pb + 10)) { PH_LOCALS();
            pg8::Gemm g{act_p, (const bf16*)(wl + WO_DN2), TP, D, FF}; pg8::TailSplitOrder<TSP> S; S.init(TP, D, FF, G_, bx_);
            pg8::EpiResid E{hbuf_p, D, 0.5f, (float*)(ws_p + WS_SLAB)};
            pg8::gemm_phase<pg8::EpiResid, pg8::TailSplitOrder<TSP>, true, true>(lds, g, S, E, wave);
            CONVERT_IN_TAIL(S.ntail() * TSP, CV5, CV6);
            SEAM(pb + 10);
        }
        if (IN(pb + 11)) { PH_LOCALS();
            if (l_p + 1 < DEPTH) norm_phase<0>(nullptr, nullptr, nullptr, hbuf_p, args.in[5] + (size_t)(l_p + 1) * D, xn_p, nullptr, gw_p, ngw_p, lane_p, (const float*)(ws_p + WS_SLAB), 0.5f, FF, G_, lds, tid_p);
            else norm_phase<2>(nullptr, nullptr, nullptr, hbuf_p, args.in[19], nullptr, args.out, gw_p, ngw_p, lane_p, (const float*)(ws_p + WS_SLAB), 0.5f, FF, G_, lds, tid_p);
            SEAM(pb + 11);
        }
    }
#undef PH_LOCALS
#undef CONVERT_RANGE
#undef CONVERT_IN_TAIL
#undef IN
#undef SEAM
}

extern "C" void kernel_launch(void* const* d_in, const int* in_sizes, int n_in, void* d_out, int out_size, void* d_ws, size_t ws_size, hipStream_t stream) {
    static int grid = 0;
    if (grid == 0) {
        if (n_in != 20 || (size_t)out_size != O_END || ws_size < WS_END) { fprintf(stderr, "kernel_launch: unexpected shapes (n_in %d, out %d, ws %zu); nothing launched\n", n_in, out_size, ws_size); grid = -1; return; }
        int dev = 0, cus = 0, per_cu = 0;
        if (hipGetDevice(&dev) != hipSuccess || hipDeviceGetAttribute(&cus, hipDeviceAttributeMultiprocessorCount, dev) != hipSuccess) { grid = -1; return; }
        if (hipFuncSetAttribute((const void*)mk_fwd, hipFuncAttributeMaxDynamicSharedMemorySize, LDS_BYTES) != hipSuccess) { fprintf(stderr, "kernel_launch: hipFuncSetAttribute failed\n"); grid = -1; return; }
        if (hipOccupancyMaxActiveBlocksPerMultiprocessor(&per_cu, (const void*)mk_fwd, NWAVES * 64, LDS_BYTES) != hipSuccess || per_cu < 1)
            fprintf(stderr, "kernel_launch: occupancy query reports %d workgroups per CU\n", per_cu);
        (void)hipGetLastError();
        grid = cus;
        if (grid < 32) grid = 32;
    }
    if (grid < 0) return;
    (void)hipMemsetAsync((char*)d_ws + WS_CTL, 0, CTL_ZERO_BYTES, stream);
    Args a{};
    for (int i = 0; i < 20; ++i) a.in[i] = (const float*)d_in[i];
    a.out = (float*)d_out; a.ws = (unsigned char*)d_ws;
    if (MK_N_LAUNCHES == 1) {
        a.ph_lo = 0; a.ph_hi = N_PHASES;
        hipLaunchKernelGGL(mk_fwd, dim3(grid), dim3(NWAVES * 64), LDS_BYTES, stream, a);
    } else {
        for (int p = 0; p < N_PHASES; ++p) { a.ph_lo = p; a.ph_hi = p + 1; hipLaunchKernelGGL(mk_fwd, dim3(grid), dim3(NWAVES * 64), LDS_BYTES, stream, a); }
    }
}
```

```cpp
#include <hip/hip_runtime.h>
#include <cstdio>
#include <cstdint>

#ifndef MK_N_LAUNCHES
#define MK_N_LAUNCHES 1
#endif

__device__ __forceinline__ int fresh_lane() { unsigned z = 0u; asm volatile("" : "+s"(z)); return (int)__builtin_amdgcn_mbcnt_hi(~0u, __builtin_amdgcn_mbcnt_lo(~0u, z)); }
namespace pg8 {
#define PG8_LAS __attribute__((address_space(3)))
#define PG8_GAS __attribute__((address_space(1)))
typedef unsigned short bf16_t;
typedef short bf16x8 __attribute__((ext_vector_type(8)));
typedef float f32x4 __attribute__((ext_vector_type(4)));
typedef unsigned u32x4 __attribute__((ext_vector_type(4)));
constexpr int BM = 256, BK = 64, HALF = 128, HTB = HALF * BK * 2  , STAGE_BYTES = 8 * HTB, NXCD = 8, WGM = 8;

__host__ __device__ __forceinline__ int lds_byte(int r, int c) { const int st = (r >> 4) * 2 + (c >> 5), rr = r & 15, cc = c & 31, ob = rr * 64 + cc * 2; return st * 1024 + (ob ^ (((ob >> 9) & 1) << 5)); }
__host__ __device__ __forceinline__ void stage_rc(int b, int& R, int& C) { const int st = b / 1024, sb = b % 1024, swz = sb ^ (((sb >> 9) & 1) << 5); R = (st >> 1) * 16 + swz / 64; C = (st & 1) * 32 + (swz % 64) / 2; }
__host__ __device__ __forceinline__ int perm32(int rho) { const int n = rho >> 4, i = rho & 15; return 8 * (i >> 2) + 4 * n + (i & 3); }

struct Unit { int pm, pn, kt0, nkt, slab; };
struct Gemm { const bf16_t* A; const bf16_t* Bt; int M, N, K; };

struct StaticOrder {
    int nM, nN, nwg, G, c, nkt;
    __host__ __device__ void init(int M, int N, int K, int G_, int c_) { nM = M / BM; nN = N / BM; nwg = nM * nN; G = G_; c = c_; nkt = K / BK; }
    __host__ __device__ bool next(int i, Unit& u) const {
        const long L = (long)i * G + c; if (L >= nwg) return false;
        u.kt0 = 0; u.nkt = nkt; u.slab = -1;
        int wgid = (int)L; { const int q = nwg / NXCD, r = nwg % NXCD, xcd = wgid % NXCD, off = wgid / NXCD; wgid = (xcd < r ? xcd * (q + 1) : r * (q + 1) + (xcd - r) * q) + off; }
        const int nig = WGM * nN, gid = wgid / nig, fm = gid * WGM, gsz = (nM - fm) < WGM ? (nM - fm) : WGM;
        u.pm = fm + ((wgid % nig) % gsz); u.pn = (wgid % nig) / gsz; return true;
    }
    __device__ __forceinline__ void a_ready(const Unit&) const {}
    __device__ __forceinline__ void done(const Unit&) const {}
};

template <int SP> struct TailSplitOrder : StaticOrder {
    __host__ __device__ int ntail() const { return nwg % G; }
    __host__ __device__ int rounds() const { return nwg / G; }
    __host__ __device__ bool tail_unit(int tu, Unit& u) const { StaticOrder t = *this; t.c = tu; return t.next(rounds(), u); }
    __host__ __device__ bool next(int i, Unit& u) const {
        const int R = rounds(), nt = ntail();
        if (i < R) return StaticOrder::next(i, u);
        if (i > R || nt == 0) return false;
        if (nt * SP > G || (nkt % (2 * SP)) != 0) return StaticOrder::next(i, u);
        if (c >= nt * SP) return false;
        const int tu = c % nt, ks = c / nt;
        if (!tail_unit(tu, u)) return false;
        u.nkt = nkt / SP; u.kt0 = ks * u.nkt; u.slab = tu * SP + ks; return true;
    }
};

typedef __bf16 bf16x2v __attribute__((ext_vector_type(2)));
typedef float f32x2v __attribute__((ext_vector_type(2)));
__device__ __forceinline__ unsigned cvt_pk_bf16(float lo, float hi) { const f32x2v v = {lo, hi}; const bf16x2v r = __builtin_convertvector(v, bf16x2v); return __builtin_bit_cast(unsigned, r); }

struct EpiBf16 {
    static constexpr bool PERM = true, AFTER_DRAIN = false;
    bf16_t* O; int ldc; const float* rs;
    __device__ __forceinline__ void operator()(const f32x4 (&acc)[2][2][4][2], const Unit& u, int wr, int wc, int fr, int fq) const {
        const int row0 = u.pm * BM + wr * 64 + fr; const int col0 = u.pn * BM + wc * 32 + 8 * fq;
#pragma unroll
        for (int ai = 0; ai < 2; ++ai)
#pragma unroll
            for (int m = 0; m < 4; ++m) { PG8_GAS bf16_t* rowp = (PG8_GAS bf16_t*)O + (size_t)(row0 + ai * HALF + m * 16) * ldc + col0; const float r = ((const PG8_GAS float*)rs)[row0 + ai * HALF + m * 16];
#pragma unroll
                for (int bj = 0; bj < 2; ++bj) { const f32x4 v0 = acc[ai][bj][m][0] * r, v1 = acc[ai][bj][m][1] * r;
                    u32x4 w; w.x = cvt_pk_bf16(v0[0], v0[1]); w.y = cvt_pk_bf16(v0[2], v0[3]); w.z = cvt_pk_bf16(v1[0], v1[1]); w.w = cvt_pk_bf16(v1[2], v1[3]);
                    *(PG8_GAS u32x4*)(rowp + bj * HALF) = w; } }
    }
};
struct EpiSwiGLU {
    static constexpr bool PERM = true, AFTER_DRAIN = false;
    bf16_t* O; int ldc; const float* rs;
    __device__ __forceinline__ static float silu_mul(float a, float b) { return a * __builtin_amdgcn_rcpf(1.0f + __builtin_amdgcn_exp2f(-1.44269504089f * a)) * b; }
    __device__ __forceinline__ void operator()(const f32x4 (&acc)[2][2][4][2], const Unit& u, int wr, int wc, int fr, int fq) const {
        const int row0 = u.pm * BM + wr * 64 + fr; const int col0 = u.pn * HALF + wc * 32 + 8 * fq;
#pragma unroll
        for (int ai = 0; ai < 2; ++ai)
#pragma unroll
            for (int m = 0; m < 4; ++m) { PG8_GAS bf16_t* rowp = (PG8_GAS bf16_t*)O + (size_t)(row0 + ai * HALF + m * 16) * ldc + col0;
                const float r = ((const PG8_GAS float*)rs)[row0 + ai * HALF + m * 16];
                const f32x4 a0 = acc[ai][0][m][0] * r, a1 = acc[ai][0][m][1] * r, b0 = acc[ai][1][m][0] * r, b1 = acc[ai][1][m][1] * r;
                f32x4 e0, e1;
#pragma unroll
                for (int j = 0; j < 4; ++j) { e0[j] = __builtin_amdgcn_exp2f(-1.44269504089f * a0[j]); e1[j] = __builtin_amdgcn_exp2f(-1.44269504089f * a1[j]); }
                f32x4 r0, r1;
#pragma unroll
                for (int j = 0; j < 4; ++j) { r0[j] = __builtin_amdgcn_rcpf(1.0f + e0[j]); r1[j] = __builtin_amdgcn_rcpf(1.0f + e1[j]); }
                const f32x4 s0 = a0 * r0 * b0, s1 = a1 * r1 * b1;
                u32x4 w; w.x = cvt_pk_bf16(s0[0], s0[1]); w.y = cvt_pk_bf16(s0[2], s0[3]); w.z = cvt_pk_bf16(s1[0], s1[1]); w.w = cvt_pk_bf16(s1[2], s1[3]);
                *(PG8_GAS u32x4*)rowp = w; }
    }
};
struct EpiResid {
    static constexpr bool PERM = false, AFTER_DRAIN = false;
    bf16_t* C; int ldc; float scale; float* slabs;
    __device__ __forceinline__ void operator()(const f32x4 (&acc)[2][2][4][2], const Unit& u, int wr, int wc, int fr, int fq) const {
        if (u.slab >= 0) {
            typedef unsigned u32x2 __attribute__((ext_vector_type(2)));
            PG8_GAS bf16_t* sp = (PG8_GAS bf16_t*)slabs + (size_t)u.slab * (BM * BM) + (size_t)(wr * 64 + fr) * BM + wc * 32 + 4 * fq;
#pragma unroll
            for (int ai = 0; ai < 2; ++ai)
#pragma unroll
                for (int m = 0; m < 4; ++m)
#pragma unroll
                    for (int bj = 0; bj < 2; ++bj)
#pragma unroll
                        for (int n = 0; n < 2; ++n) { const f32x4 v = acc[ai][bj][m][n]; *(PG8_GAS u32x2*)(sp + (size_t)(ai * HALF + m * 16) * BM + bj * HALF + n * 16) = (u32x2){cvt_pk_bf16(v[0], v[1]), cvt_pk_bf16(v[2], v[3])}; }
            return;
        }
        const int row0 = u.pm * BM + wr * 64 + fr, col0 = u.pn * BM + wc * 32 + 4 * fq;
        typedef unsigned u32x2 __attribute__((ext_vector_type(2)));
        u32x2 old[2][4][2][2];
#pragma unroll
        for (int ai = 0; ai < 2; ++ai)
#pragma unroll
            for (int m = 0; m < 4; ++m) { const PG8_GAS bf16_t* rowp = (const PG8_GAS bf16_t*)C + (size_t)(row0 + ai * HALF + m * 16) * ldc + col0;
#pragma unroll
                for (int bj = 0; bj < 2; ++bj)
#pragma unroll
                    for (int n = 0; n < 2; ++n) old[ai][m][bj][n] = *(const PG8_GAS u32x2*)(rowp + bj * HALF + n * 16); }
#pragma unroll
        for (int ai = 0; ai < 2; ++ai)
#pragma unroll
            for (int m = 0; m < 4; ++m) { PG8_GAS bf16_t* rowp = (PG8_GAS bf16_t*)C + (size_t)(row0 + ai * HALF + m * 16) * ldc + col0;
#pragma unroll
                for (int bj = 0; bj < 2; ++bj)
#pragma unroll
                    for (int n = 0; n < 2; ++n) { const u32x2 o = old[ai][m][bj][n]; const f32x4 a = acc[ai][bj][m][n];
                        const float y0 = __builtin_bit_cast(float, o.x << 16) + a[0] * scale, y1 = __builtin_bit_cast(float, o.x & 0xffff0000u) + a[1] * scale;
                        const float y2 = __builtin_bit_cast(float, o.y << 16) + a[2] * scale, y3 = __builtin_bit_cast(float, o.y & 0xffff0000u) + a[3] * scale;
                        *(PG8_GAS u32x2*)(rowp + bj * HALF + n * 16) = (u32x2){cvt_pk_bf16(y0, y1), cvt_pk_bf16(y2, y3)}; } }
    }
};

template <class Epi, class Sched, bool ALIGN_EPI = false, bool SP2 = false>
__device__ __forceinline__ void gemm_phase(PG8_LAS unsigned char* lds, const Gemm g, const Sched& S, const Epi& E, const int wave_id) {
    int tid_ = wave_id * 64 + fresh_lane(); asm volatile("" : "+v"(tid_));
    const int tid = tid_, wid = __builtin_amdgcn_readfirstlane(tid >> 6), lane = tid & 63, wr = wid >> 2, wc = wid & 3, fr = lane & 15, fq = lane >> 4;
    const int K = g.K;
    unsigned voffA[2], voffB[2];
#pragma unroll
    for (int i = 0; i < 2; ++i) { int R, C; stage_rc(tid * 16 + i * 8192, R, C); const int Rb = Epi::PERM ? ((R & ~31) + perm32(R & 31)) : R;
        voffA[i] = (unsigned)(R * K + C) * 2u; voffB[i] = (unsigned)(Rb * K + C) * 2u; }
    const size_t kstep = (size_t)(BK * 2);
    const size_t hstep = (size_t)HALF * K * 2;
    const size_t tstep = 2 * hstep;
    const unsigned ldsw = (unsigned)wid * 1024u;
    const int aoff = lds_byte(wr * 64 + fr, fq * 8), boff = lds_byte(wc * 32 + fr, fq * 8);
#define PG8_SA(b, h) (((b) * 2 + (h)) * HTB)
#define PG8_SB(b, h) ((4 + (b) * 2 + (h)) * HTB)
#define PG8_STAGE(bufoff, gbase, voff) do { _Pragma("unroll") for (int _i = 0; _i < 2; ++_i) \
        __builtin_amdgcn_global_load_lds((const unsigned*)((const char*)(gbase) + (voff)[_i]), (PG8_LAS unsigned*)(lds + (bufoff) + ldsw + _i * 8192), 16, 0, 0); } while (0)
#define PG8_LDA(dst, b, h) do { _Pragma("unroll") for (int m = 0; m < 4; ++m) _Pragma("unroll") for (int k = 0; k < 2; ++k) dst[m][k] = *(const PG8_LAS bf16x8*)(lds + PG8_SA(b, h) + aoff + m * 2048 + k * 1024); } while (0)
#define PG8_LDB(dst, b, h) do { _Pragma("unroll") for (int n = 0; n < 2; ++n) _Pragma("unroll") for (int k = 0; k < 2; ++k) dst[n][k] = *(const PG8_LAS bf16x8*)(lds + PG8_SB(b, h) + boff + n * 2048 + k * 1024); } while (0)
#define PG8_MMA(ai, bj, At, Bt) do { __builtin_amdgcn_s_setprio(1); _Pragma("unroll") for (int m = 0; m < 4; ++m) _Pragma("unroll") for (int n = 0; n < 2; ++n) _Pragma("unroll") for (int k = 0; k < 2; ++k) \
        acc[ai][bj][m][n] = __builtin_amdgcn_mfma_f32_16x16x32_bf16(Bt[n][k], At[m][k], acc[ai][bj][m][n], 0, 0, 0); __builtin_amdgcn_s_setprio(0); } while (0)
#define PG8_WAIT_V(n) asm volatile("s_waitcnt vmcnt(" #n ")" ::: "memory")
#define PG8_WAIT_L(n) asm volatile("s_waitcnt lgkmcnt(" #n ")" ::: "memory")
#define PG8_BAR __builtin_amdgcn_s_barrier()
#define PG8_SCHED __builtin_amdgcn_sched_barrier(0)
    Unit cur, nxt; int ui = 0;
    if (!S.next(0, cur)) return;
    f32x4 acc[2][2][4][2];
#pragma unroll
    for (int a = 0; a < 2; ++a)
#pragma unroll
        for (int b = 0; b < 2; ++b)
#pragma unroll
            for (int m = 0; m < 4; ++m)
#pragma unroll
                for (int n = 0; n < 2; ++n) acc[a][b][m][n] = (f32x4){0.f, 0.f, 0.f, 0.f};
    bf16x8 At[4][2], B0[2][2], B1[2][2];
    const char* cA = (const char*)g.A + (size_t)cur.pm * tstep + (size_t)cur.kt0 * kstep; const char* cB = (const char*)g.Bt + (size_t)cur.pn * tstep + (size_t)cur.kt0 * kstep;
    S.a_ready(cur);
    if constexpr (SP2) {
        PG8_STAGE(PG8_SB(0, 0), cB, voffB); PG8_STAGE(PG8_SB(0, 1), cB + hstep, voffB); PG8_STAGE(PG8_SA(0, 0), cA, voffA); PG8_STAGE(PG8_SA(0, 1), cA + hstep, voffA);
        if (wr == 1) PG8_BAR;
        PG8_WAIT_V(2); PG8_BAR;
        PG8_STAGE(PG8_SB(1, 0), cB + kstep, voffB); PG8_STAGE(PG8_SA(1, 0), cA + kstep, voffA); PG8_STAGE(PG8_SB(1, 1), cB + hstep + kstep, voffB);
        PG8_WAIT_V(6); PG8_BAR;
    } else {
        PG8_STAGE(PG8_SB(0, 0), cB, voffB); PG8_STAGE(PG8_SA(0, 0), cA, voffA); PG8_STAGE(PG8_SB(0, 1), cB + hstep, voffB); PG8_STAGE(PG8_SA(0, 1), cA + hstep, voffA);
        if (wr == 1) PG8_BAR;
        PG8_WAIT_V(4); PG8_BAR;
        PG8_STAGE(PG8_SB(1, 0), cB + kstep, voffB); PG8_STAGE(PG8_SA(1, 0), cA + kstep, voffA); PG8_STAGE(PG8_SB(1, 1), cB + hstep + kstep, voffB);
        PG8_WAIT_V(6); PG8_BAR;
    }
    for (;;) {
        const bool has_next = S.next(ui + 1, nxt);
        const char* nA = has_next ? (const char*)g.A + (size_t)nxt.pm * tstep + (size_t)nxt.kt0 * kstep : cA; const char* nB = has_next ? (const char*)g.Bt + (size_t)nxt.pn * tstep + (size_t)nxt.kt0 * kstep : cB;
        const int nt = cur.nkt;
        for (int t = 0; t < nt; t += 2) {
            const bool last = (t == nt - 2);
            const char* a1 = cA + (size_t)(t + 1) * kstep;
            const char* a2 = last ? nA : cA + (size_t)(t + 2) * kstep; const char* b2 = last ? nB : cB + (size_t)(t + 2) * kstep;
            const char* a3 = a2 + kstep; const char* b3 = b2 + kstep;
            if (last && has_next) S.a_ready(nxt);
            if constexpr (SP2) {
            PG8_LDB(B0, 0, 0); PG8_LDB(B1, 0, 1); PG8_SCHED; PG8_LDA(At, 0, 0); PG8_STAGE(PG8_SA(1, 1), a1 + hstep, voffA);
            PG8_WAIT_V(8); PG8_WAIT_L(0); PG8_BAR; PG8_MMA(0, 0, At, B0); PG8_MMA(0, 1, At, B1); PG8_BAR; PG8_SCHED;
            PG8_LDA(At, 0, 1); PG8_STAGE(PG8_SB(0, 0), b2, voffB); PG8_STAGE(PG8_SB(0, 1), b2 + hstep, voffB); PG8_STAGE(PG8_SA(0, 0), a2, voffA);
            PG8_WAIT_V(8); PG8_WAIT_L(0); PG8_BAR; PG8_MMA(1, 0, At, B0); PG8_MMA(1, 1, At, B1); PG8_BAR; PG8_SCHED;
            PG8_LDB(B0, 1, 0); PG8_LDB(B1, 1, 1); PG8_SCHED; PG8_LDA(At, 1, 0); PG8_STAGE(PG8_SA(0, 1), a2 + hstep, voffA);
            PG8_WAIT_V(8); PG8_WAIT_L(0); PG8_BAR; PG8_MMA(0, 0, At, B0); PG8_MMA(0, 1, At, B1); PG8_BAR; PG8_SCHED;
            PG8_LDA(At, 1, 1); PG8_STAGE(PG8_SB(1, 0), b3, voffB); PG8_STAGE(PG8_SB(1, 1), b3 + hstep, voffB); PG8_STAGE(PG8_SA(1, 0), a3, voffA);
            PG8_WAIT_V(8); PG8_WAIT_L(0); PG8_BAR; PG8_MMA(1, 0, At, B0); PG8_MMA(1, 1, At, B1); PG8_BAR; PG8_SCHED;
            } else {
            PG8_LDB(B0, 0, 0); PG8_SCHED; PG8_LDA(At, 0, 0); PG8_STAGE(PG8_SA(1, 1), a1 + hstep, voffA);
            PG8_WAIT_L(8); PG8_BAR; PG8_WAIT_L(0); PG8_MMA(0, 0, At, B0); PG8_BAR; PG8_SCHED;
            PG8_LDB(B1, 0, 1); PG8_STAGE(PG8_SB(0, 0), b2, voffB);
            PG8_BAR; PG8_WAIT_L(0); PG8_MMA(0, 1, At, B1); PG8_BAR;
            PG8_LDA(At, 0, 1); PG8_STAGE(PG8_SA(0, 0), a2, voffA);
            PG8_BAR; PG8_WAIT_L(0); PG8_MMA(1, 0, At, B0); PG8_BAR; PG8_SCHED;
            PG8_STAGE(PG8_SB(0, 1), b2 + hstep, voffB);
            PG8_WAIT_V(6); PG8_BAR; PG8_MMA(1, 1, At, B1); PG8_BAR;
            PG8_LDB(B0, 1, 0); PG8_SCHED; PG8_LDA(At, 1, 0); PG8_STAGE(PG8_SA(0, 1), a2 + hstep, voffA);
            PG8_WAIT_L(8); PG8_BAR; PG8_WAIT_L(0); PG8_MMA(0, 0, At, B0); PG8_BAR; PG8_SCHED;
            PG8_LDB(B1, 1, 1); PG8_STAGE(PG8_SB(1, 0), b3, voffB);
            PG8_BAR; PG8_WAIT_L(0); PG8_MMA(0, 1, At, B1); PG8_BAR;
            PG8_LDA(At, 1, 1); PG8_STAGE(PG8_SA(1, 0), a3, voffA);
            PG8_BAR; PG8_WAIT_L(0); PG8_MMA(1, 0, At, B0); PG8_BAR; PG8_SCHED;
            PG8_STAGE(PG8_SB(1, 1), b3 + hstep, voffB);
            PG8_WAIT_V(6); PG8_BAR; PG8_MMA(1, 1, At, B1); PG8_BAR;
            }
        }
        if constexpr (ALIGN_EPI) { if (wr == 0) PG8_BAR; }
        if constexpr (!Epi::AFTER_DRAIN) { E(acc, cur, wr, wc, fr, fq); S.done(cur); }
        if (!has_next) break;
#pragma unroll
        for (int a = 0; a < 2; ++a)
#pragma unroll
            for (int b = 0; b < 2; ++b)
#pragma unroll
                for (int m = 0; m < 4; ++m)
#pragma unroll
                    for (int n = 0; n < 2; ++n) acc[a][b][m][n] = (f32x4){0.f, 0.f, 0.f, 0.f};
        cur = nxt; cA = nA; cB = nB; ++ui;
        if constexpr (ALIGN_EPI) { if (wr == 1) PG8_BAR; }
    }
    PG8_WAIT_V(0);
    if constexpr (!ALIGN_EPI) { if (wr == 0) PG8_BAR; }
    PG8_BAR;
#undef PG8_SA
#undef PG8_SB
#undef PG8_STAGE
#undef PG8_LDA
#undef PG8_LDB
#undef PG8_MMA
#undef PG8_WAIT_V
#undef PG8_WAIT_L
#undef PG8_BAR
#undef PG8_SCHED
}
}

constexpr int NWAVES = 8;
constexpr int D = 2048, FF = 5632, NGU = 2 * FF, DEPTH = 4;
constexpr int DCONV = 1024, GH = 4, GDK = 128, GDV = 256, GRANK = 16;
constexpr int NIN = 6160, NINP = 6400;
constexpr int R_SAMPLE = 8192, R_META = 9216, T_REAL = 9280, TP = 9472;
constexpr int PC_B = 0, PC_C = 1024, PC_H = 2048, PC_Q = 3072, PC_K = 3584, PC_V = 4096, PC_GO = 5120, PC_FL = 6144;
constexpr float EPS = 1e-6f;
constexpr size_t O_YP = 0, O_YS = 16777216, O_GP = 18874368, O_CP = 20971520, O_GS = 21004288, O_CS = 88113152, O_END = 89161728;
constexpr size_t MiB = 1u << 20;
constexpr size_t WS_CTL = 0, CTL_ZERO_BYTES = 32768;
constexpr size_t WS_W = 2 * MiB, W_LAYER = 165 * MiB;
constexpr size_t WO_GU1 = 0, WO_DN1 = 44 * MiB, WO_IN = 66 * MiB, WO_OUT = 91 * MiB, WO_GU2 = 99 * MiB, WO_DN2 = 143 * MiB;
constexpr size_t WS_H = 664 * MiB, WS_XN = 738 * MiB, WS_ACT = 776 * MiB, WS_PROJ = 878 * MiB, WS_YMIX = 994 * MiB, WS_SLAB = 1032 * MiB, WS_GQS = 1096 * MiB, WS_GPL = 1105 * MiB, WS_GEBL = 1110 * MiB, WS_GU = 1111 * MiB, WS_GS = 1177 * MiB, WS_END = 1210 * MiB;
static_assert(WS_W + DEPTH * W_LAYER <= WS_H && WS_H + (size_t)TP * D * 4 <= WS_XN && WS_XN + (size_t)TP * D * 2 <= WS_ACT && WS_ACT + (size_t)TP * FF * 2 <= WS_PROJ &&
              WS_PROJ + (size_t)TP * NINP * 2 <= WS_YMIX && WS_YMIX + (size_t)TP * D * 2 <= WS_SLAB && WS_SLAB + (size_t)256 * 65536 * 4 <= WS_GQS && WS_GQS + (size_t)528 * 16384 <= WS_GPL && WS_GPL + (size_t)528 * 8192 <= WS_GEBL && WS_GEBL + (size_t)528 * 512 <= WS_GU && WS_GU + (size_t)528 * 131072 <= WS_GS && WS_GS + (size_t)528 * 65536 <= WS_END, "d_ws map");
constexpr int TSP = 4;
constexpr int CW_BAR = 4096;
static_assert((CW_BAR + 3456) * 4 <= (int)CTL_ZERO_BYTES, "the per-call memset covers the barrier words");
constexpr int LDS_BYTES = 147456, MISC_OFF = 143360;

#define GAS __attribute__((address_space(1)))
#define LAS __attribute__((address_space(3)))
typedef unsigned short bf16;
typedef unsigned v4u __attribute__((ext_vector_type(4)));
typedef unsigned v2u __attribute__((ext_vector_type(2)));
typedef float f32x4 __attribute__((ext_vector_type(4)));
typedef float f32x2 __attribute__((ext_vector_type(2)));
#define DI __device__ __forceinline__
#define LDS_WAIT() asm volatile("s_waitcnt lgkmcnt(0)" ::: "memory")
DI unsigned f2bf(float f) { unsigned u = __builtin_bit_cast(unsigned, f); return (u + 0x7fffu + ((u >> 16) & 1u)) >> 16; }
typedef __bf16 bf16x2_t __attribute__((ext_vector_type(2)));
DI unsigned pk2(float lo, float hi) { f32x2 v = {lo, hi}; bf16x2_t r = __builtin_convertvector(v, bf16x2_t); return __builtin_bit_cast(unsigned, r); }
DI float bflo(unsigned w) { return __uint_as_float(w << 16); }
DI float bfhi(unsigned w) { return __uint_as_float(w & 0xffff0000u); }

#define XB_TMO      128
#define XB_XCNT(j)  (256  + 64 * (j))
#define XB_XSUB(j)  (1280 + 64 * (j))
#define XB_XGEN(j)  (2304 + 64 * (j))
#define XB_TOP      3328
#define XB_TOPGEN   3392
#define XCD_BAR_WORDS 3456
#define XB_SPIN_CAP (1u << 22)
__device__ __forceinline__ unsigned xb_ld(unsigned* p)              { return __hip_atomic_load(p, __ATOMIC_RELAXED, __HIP_MEMORY_SCOPE_AGENT); }
__device__ __forceinline__ unsigned xb_add(unsigned* p, unsigned v) { return __hip_atomic_fetch_add(p, v, __ATOMIC_RELAXED, __HIP_MEMORY_SCOPE_AGENT); }
__device__ __forceinline__ unsigned xb_xcc_id() { return (unsigned)__builtin_amdgcn_s_getreg((3 << 11) | 20) & 0xFu; }
#define XB_SPIN(cond, bar) do { unsigned _sp = 0; while (cond) { __builtin_amdgcn_s_sleep(1); \
    if ((++_sp & 255u) == 0u) { if (xb_ld(&(bar)[XB_TMO])) break; if (_sp > XB_SPIN_CAP) { atomicAdd(&(bar)[XB_TMO], 1u); break; } } } } while (0)
struct XcdBarrier { unsigned* bar; unsigned x; volatile LAS unsigned* st; };
__device__ __forceinline__ bool xb_t0(int wave_id) { return wave_id == 0 && fresh_lane() == 0; }
__device__ __forceinline__ XcdBarrier xcd_barrier_post(unsigned* bar, volatile LAS unsigned* st, int wave_id) {
    XcdBarrier b; b.bar = bar; b.x = xb_xcc_id(); b.st = st;
    if (xb_t0(wave_id)) (void)xb_add(&bar[XB_XCNT(b.x)], 1u);
    return b;
}
__device__ __forceinline__ void xcd_barrier_complete(unsigned* bar, unsigned x, unsigned& nloc, unsigned& nx) {
    const unsigned G = gridDim.x * gridDim.y * gridDim.z;
    unsigned sum, cnt, mine, sp = 0u;
    for (;;) {
        sum = 0u; cnt = 0u; mine = 0u;
#pragma unroll
        for (unsigned j = 0; j < 16; ++j) { const unsigned c = xb_ld(&bar[XB_XCNT(j)]); sum += c; cnt += (c > 0u) ? 1u : 0u; mine = (j == x) ? c : mine; }
        if (sum == G) break;
        __builtin_amdgcn_s_sleep(1);
        if ((++sp & 255u) == 0u) { if (xb_ld(&bar[XB_TMO])) break; if (sp > XB_SPIN_CAP) { atomicAdd(&bar[XB_TMO], 1u); break; } }
    }
    nloc = mine > 0u ? mine : 1u; nx = cnt > 0u ? cnt : 1u;
}
__device__ __forceinline__ void xcd_barrier(const XcdBarrier& b, int wave_id) {
    asm volatile("s_waitcnt vmcnt(0)" ::: "memory");
    __syncthreads();
    if (xb_t0(wave_id)) {
        unsigned* bar = b.bar;
        __builtin_amdgcn_s_waitcnt(0);
        unsigned nloc = b.st[0], nx = b.st[1];
        if (nloc == 0u) { xcd_barrier_complete(bar, b.x, nloc, nx); b.st[0] = nloc; b.st[1] = nx; }
        const unsigned old = xb_add(&bar[XB_XSUB(b.x)], 1u);
        const unsigned gen = old / nloc;
        if (old + 1u == (gen + 1u) * nloc) {
            __builtin_amdgcn_fence(__ATOMIC_RELEASE, "agent");
            asm volatile("s_waitcnt vmcnt(0)" ::: "memory");
            const unsigned og = xb_add(&bar[XB_TOP], 1u);
            const unsigned tg = og / nx;
            if (og + 1u == (tg + 1u) * nx) xb_add(&bar[XB_TOPGEN], 1u);
            else XB_SPIN(xb_ld(&bar[XB_TOPGEN]) == tg, bar);
            __builtin_amdgcn_fence(__ATOMIC_ACQUIRE, "agent");
            xb_add(&bar[XB_XGEN(b.x)], 1u);
            asm volatile("s_waitcnt vmcnt(0)" ::: "memory");
        } else {
            XB_SPIN(xb_ld(&bar[XB_XGEN(b.x)]) == gen, bar);
            __builtin_amdgcn_fence(__ATOMIC_ACQUIRE, "agent");
            asm volatile("s_waitcnt vmcnt(0)" ::: "memory");
        }
    }
    __syncthreads();
}

DI float wave_sum(float v) {
#pragma unroll
    for (int o = 1; o < 64; o <<= 1) v += __shfl_xor(v, o);
    return v;
}
DI int row_prompt(int b, int pos) { return pos < 16 ? R_META + b * 16 + pos : b * 2048 + pos - 16; }

DI int dst_row(int kind, int n) { if (kind == 0) return n; const int a = n < FF ? n : n - FF; return 256 * (a >> 7) + (n < FF ? 0 : 128) + (a & 127); }
struct CvItem { const float* W; bf16* WT; int K, N, kind, kb, nb; const float* G; };
DI void cv_load(const CvItem& it, int lane, f32x4 (&v)[16], f32x4 (&g)[2]) {
    const int k0 = 64 * it.kb, n0 = 64 * it.nb, lr = lane >> 4, lc = 4 * (lane & 15);
    const bool inb = (n0 + lc) < it.N;
#pragma unroll
    for (int i = 0; i < 16; ++i) v[i] = inb ? __builtin_nontemporal_load((const f32x4*)(it.W + (size_t)(k0 + 4 * i + lr) * it.N + n0 + lc)) : (f32x4){0.f, 0.f, 0.f, 0.f};
    if (it.G) { g[0] = *(const f32x4*)(it.G + k0 + 8 * (lane & 7)); g[1] = *(const f32x4*)(it.G + k0 + 8 * (lane & 7) + 4); } else { g[0] = (f32x4){1.f, 1.f, 1.f, 1.f}; g[1] = g[0]; }
}
DI void cv_finish(const CvItem& it, const f32x4 (&v)[16], const f32x4 (&g)[2], LAS float* scr, int lane) {
    const int k0 = 64 * it.kb, n0 = 64 * it.nb, lr = lane >> 4, lc = 4 * (lane & 15);
#pragma unroll
    for (int i = 0; i < 16; ++i) { LAS float* s = scr + (4 * i + lr) * 65 + lc; s[0] = v[i][0]; s[1] = v[i][1]; s[2] = v[i][2]; s[3] = v[i][3]; }
    LDS_WAIT(); asm volatile("" ::: "memory");
    const int c = lane & 7;
#pragma unroll
    for (int j = 0; j < 8; ++j) { const int nl = (lane >> 3) + 8 * j, n = n0 + nl; const LAS float* s = scr + (8 * c) * 65 + nl;
        v4u o; o.x = pk2(s[0 * 65] * g[0][0], s[1 * 65] * g[0][1]); o.y = pk2(s[2 * 65] * g[0][2], s[3 * 65] * g[0][3]); o.z = pk2(s[4 * 65] * g[1][0], s[5 * 65] * g[1][1]); o.w = pk2(s[6 * 65] * g[1][2], s[7 * 65] * g[1][3]);
        if (n < it.N) *(v4u*)(it.WT + (size_t)dst_row(it.kind, n) * it.K + k0 + 8 * c) = o; }
    LDS_WAIT(); asm volatile("" ::: "memory");
}
constexpr int I_GU = 32 * 176, I_DN = 88 * 32, I_IN = 32 * 97, I_OUT = 32 * 32, I_LAYER = 2 * I_GU + 2 * I_DN + I_IN + I_OUT;
DI CvItem cv_decode(const float* g1, const float* d1, const float* wi, const float* wo, const float* g2, const float* d2, const float* n1, const float* nm, const float* n2, unsigned char* wbase, int g) {
    const int l = g / I_LAYER; int r = g - l * I_LAYER; unsigned char* wl = wbase + (size_t)l * W_LAYER;
    if (r < I_GU) return CvItem{g1 + (size_t)l * D * NGU, (bf16*)(wl + WO_GU1), D, NGU, 1, r / 176, r % 176, n1 + (size_t)l * D}; r -= I_GU;
    if (r < I_DN) return CvItem{d1 + (size_t)l * FF * D, (bf16*)(wl + WO_DN1), FF, D, 0, r / 32, r % 32, nullptr}; r -= I_DN;
    if (r < I_IN) return CvItem{wi + (size_t)l * D * NIN, (bf16*)(wl + WO_IN), D, NIN, 0, r / 97, r % 97, nm + (size_t)l * D}; r -= I_IN;
    if (r < I_OUT) return CvItem{wo + (size_t)l * D * D, (bf16*)(wl + WO_OUT), D, D, 0, r / 32, r % 32, nullptr}; r -= I_OUT;
    if (r < I_GU) return CvItem{g2 + (size_t)l * D * NGU, (bf16*)(wl + WO_GU2), D, NGU, 1, r / 176, r % 176, n2 + (size_t)l * D}; r -= I_GU;
    return CvItem{d2 + (size_t)l * FF * D, (bf16*)(wl + WO_DN2), FF, D, 0, r / 32, r % 32, nullptr};
}
DI void convert_range(const float* g1, const float* d1, const float* wi, const float* wo, const float* g2, const float* d2, const float* n1, const float* nm, const float* n2, unsigned char* wl, int ib, int ie, int widx, int wstride, LAS float* scr, int lane) {
    int it = ib + widx; if (it >= ie) return;
    CvItem cur = cv_decode(g1, d1, wi, wo, g2, d2, n1, nm, n2, wl, it), nx = cur; f32x4 va[16], vb[16], ga[2], gb[2];
    cv_load(cur, lane, va, ga);
    for (;;) {
        bool has = it + wstride < ie;
        if (has) { nx = cv_decode(g1, d1, wi, wo, g2, d2, n1, nm, n2, wl, it + wstride); cv_load(nx, lane, vb, gb); }
        cv_finish(cur, va, ga, scr, lane);
        if (!has) break;
        it += wstride; cur = nx;
        has = it + wstride < ie;
        if (has) { nx = cv_decode(g1, d1, wi, wo, g2, d2, n1, nm, n2, wl, it + wstride); cv_load(nx, lane, va, ga); }
        cv_finish(cur, vb, gb, scr, lane);
        if (!has) break;
        it += wstride; cur = nx;
    }
}

template <int MODE>
DI bool norm_load(int row, const GAS float* xp, const GAS float* xs, const GAS float* meta, GAS bf16* h, GAS float* rs, const GAS float* slabs, float scale, LAS int* tmap, int lane, f32x4 (&v)[8]) {
    if (row >= TP) return false;
    if (row >= T_REAL) {
        if (MODE != 2) {
#pragma unroll
            for (int j = 0; j < 8; ++j) { if (MODE == 1) ((GAS v2u*)(h + (size_t)row * D))[lane + 64 * j] = (v2u){0u, 0u}; }
            if (lane == 0) rs[row] = 0.f;
        }
        return false;
    }
    if (MODE == 2 && row >= R_META) return false;
    if (MODE == 1) {
        const GAS float* src = row < R_SAMPLE ? xp + (size_t)row * D : (row < R_META ? xs + (size_t)(row - R_SAMPLE) * D : meta + (size_t)((row - R_META) & 15) * D);
#pragma unroll
        for (int j = 0; j < 8; ++j) v[j] = __builtin_nontemporal_load((const GAS f32x4*)src + lane + 64 * j);
    } else {
        v2u w[8];
#pragma unroll
        for (int j = 0; j < 8; ++j) w[j] = ((const GAS v2u*)(h + (size_t)row * D))[lane + 64 * j];
#pragma unroll
        for (int j = 0; j < 8; ++j) v[j] = (f32x4){bflo(w[j].x), bfhi(w[j].x), bflo(w[j].y), bfhi(w[j].y)};
    }
    if (MODE != 1) {
#pragma unroll
        for (int j = 0; j < 8; ++j) {
            const int tu = __builtin_amdgcn_readfirstlane(tmap[(row >> 8) * 8 + j]);
            if (tu >= 0) { const GAS bf16* sp = (const GAS bf16*)slabs + (size_t)tu * TSP * 65536 + (size_t)(row & 255) * 256 + 4 * lane; f32x4 a = (f32x4){0.f, 0.f, 0.f, 0.f};
#pragma unroll
                for (int ks = 0; ks < TSP; ++ks) { const v2u w2 = __builtin_nontemporal_load((const GAS v2u*)(sp + (size_t)ks * 65536)); a += (f32x4){bflo(w2.x), bfhi(w2.x), bflo(w2.y), bfhi(w2.y)}; }
                v[j] += a * scale;
                if (MODE == 0) ((GAS v2u*)(h + (size_t)row * D))[lane + 64 * j] = (v2u){pk2(v[j][0], v[j][1]), pk2(v[j][2], v[j][3])}; }
        }
    }
    return true;
}
template <int MODE>
DI void norm_finish(int row, const f32x4 (&v)[8], GAS bf16* h, const GAS float* gain, GAS float* rs, GAS float* out, int lane) {
    float ss = 0.f;
#pragma unroll
    for (int j = 0; j < 8; ++j) ss += (v[j][0] * v[j][0] + v[j][1] * v[j][1]) + (v[j][2] * v[j][2] + v[j][3] * v[j][3]);
    const float rstd = 1.0f / sqrtf(wave_sum(ss) * (1.0f / D) + EPS);
    if (MODE == 2) {
        GAS float* o = out + (row < R_SAMPLE ? O_YP + (size_t)row * D : O_YS + (size_t)(row - R_SAMPLE) * D);
#pragma unroll
        for (int j = 0; j < 8; ++j) __builtin_nontemporal_store(v[j] * rstd * ((const GAS f32x4*)gain)[lane + 64 * j], (GAS f32x4*)o + lane + 64 * j);
    } else {
        if (lane == 0) rs[row] = rstd;
        if (MODE == 1) {
#pragma unroll
            for (int j = 0; j < 8; ++j) ((GAS v2u*)(h + (size_t)row * D))[lane + 64 * j] = (v2u){pk2(v[j][0], v[j][1]), pk2(v[j][2], v[j][3])};
        }
    }
}
template <int MODE>
DI void norm_phase(const float* xp_, const float* xs_, const float* meta_, bf16* h_, const float* __restrict__ gain_, float* rs_, float* out_, int gw, int NGW, int lane,
                   const float* slabs_, float scale, int Kprev, int G, LAS unsigned char* lds, int tid) {
    const GAS float* xp = (const GAS float*)xp_; const GAS float* xs = (const GAS float*)xs_; const GAS float* meta = (const GAS float*)meta_; GAS bf16* h = (GAS bf16*)h_;
    const GAS float* gain = (const GAS float*)gain_; GAS float* rs = (GAS float*)rs_; GAS float* out = (GAS float*)out_; const GAS float* slabs = (const GAS float*)slabs_;
    LAS int* tmap = (LAS int*)lds;
    if (MODE != 1) {
        for (int i = tid; i < (TP / 256) * 8; i += NWAVES * 64) tmap[i] = -1;
        __syncthreads();
        pg8::TailSplitOrder<TSP> S; S.init(TP, D, Kprev, G, 0);
        const int nt = S.ntail(); const bool split = nt > 0 && nt * TSP <= G && (S.nkt % (2 * TSP)) == 0;
        if (split && tid < nt) { pg8::Unit u; if (S.tail_unit(tid, u)) tmap[u.pm * 8 + u.pn] = tid; }
        __syncthreads();
    }
    for (int row = gw; row < TP; row += NGW) {
        f32x4 va[8];
        if (norm_load<MODE>(row, xp, xs, meta, h, rs, slabs, scale, tmap, lane, va)) norm_finish<MODE>(row, va, h, gain, rs, out, lane);
    }
}

DI void cvt16(const v4u a, const v4u b, float (&f)[16]) {
    f[0] = bflo(a.x); f[1] = bfhi(a.x); f[2] = bflo(a.y); f[3] = bfhi(a.y); f[4] = bflo(a.z); f[5] = bfhi(a.z); f[6] = bflo(a.w); f[7] = bfhi(a.w);
    f[8] = bflo(b.x); f[9] = bfhi(b.x); f[10] = bflo(b.y); f[11] = bfhi(b.y); f[12] = bflo(b.z); f[13] = bfhi(b.z); f[14] = bflo(b.w); f[15] = bfhi(b.w); }
DI void conv_phase(const bf16* proj_, bf16* ymix_, const float* __restrict__ cw_, const float* __restrict__ cg_, const float* __restrict__ sconv_  , float* out_, int l, int gw, int NGW, int lane) {
    const GAS bf16* proj = (const GAS bf16*)proj_; GAS bf16* ymix = (GAS bf16*)ymix_; const GAS float* cw = (const GAS float*)cw_; const GAS float* cg = (const GAS float*)cg_;
    const GAS float* sconv = (const GAS float*)sconv_; GAS float* out = (GAS float*)out_;
    const int c0 = 16 * lane;
    constexpr int NRUN = 4 * 516 + 128 * 2;
    for (int ri = gw; ri < NRUN; ri += NGW) {
        const bool isp = ri < 4 * 516; const int sq = isp ? ri / 516 : (ri - 4 * 516) >> 1, p0 = isp ? 4 * (ri - sq * 516) : 4 * ((ri - 4 * 516) & 1);
#define CONV_ROW(pos) (isp ? row_prompt(sq, (pos)) : R_SAMPLE + sq * 8 + (pos))
        float u1[16], u2[16], t[16];
        if (p0 > 0) { v4u hc[2][2], hh[2][2];
#pragma unroll
            for (int k = 0; k < 2; ++k) { const GAS bf16* pr = proj + (size_t)CONV_ROW(p0 - 2 + k) * NINP + c0;
                hc[k][0] = *(const GAS v4u*)(pr + PC_C); hc[k][1] = *(const GAS v4u*)(pr + PC_C + 8); hh[k][0] = *(const GAS v4u*)(pr + PC_H); hh[k][1] = *(const GAS v4u*)(pr + PC_H + 8); }
            cvt16(hc[0][0], hc[0][1], u2); cvt16(hh[0][0], hh[0][1], t);
#pragma unroll
            for (int i = 0; i < 16; ++i) u2[i] *= t[i];
            cvt16(hc[1][0], hc[1][1], u1); cvt16(hh[1][0], hh[1][1], t);
#pragma unroll
            for (int i = 0; i < 16; ++i) u1[i] *= t[i];
        } else if (!isp) {
#pragma unroll
            for (int i = 0; i < 4; ++i) { const f32x4 s0 = *(const GAS f32x4*)(sconv + ((size_t)sq * 2 + 0) * DCONV + c0 + 4 * i), s1 = *(const GAS f32x4*)(sconv + ((size_t)sq * 2 + 1) * DCONV + c0 + 4 * i);
#pragma unroll
                for (int e = 0; e < 4; ++e) { u2[4 * i + e] = s0[e]; u1[4 * i + e] = s1[e]; } }
        } else {
#pragma unroll
            for (int i = 0; i < 16; ++i) { u2[i] = 0.f; u1[i] = 0.f; }
        }
        v4u nb[2], nc[2], nh[2];
        { const GAS bf16* pr = proj + (size_t)CONV_ROW(p0) * NINP + c0;
          nb[0] = *(const GAS v4u*)(pr + PC_B); nb[1] = *(const GAS v4u*)(pr + PC_B + 8); nc[0] = *(const GAS v4u*)(pr + PC_C); nc[1] = *(const GAS v4u*)(pr + PC_C + 8); nh[0] = *(const GAS v4u*)(pr + PC_H); nh[1] = *(const GAS v4u*)(pr + PC_H + 8); }
#pragma unroll
        for (int k = 0; k < 4; ++k) {
            const int pos = p0 + k, row = CONV_ROW(pos);
            float cb[16], u0[16], y[16], w[16];
            cvt16(nb[0], nb[1], cb); cvt16(nc[0], nc[1], u0); cvt16(nh[0], nh[1], t);
            if (k < 3) { const GAS bf16* pr = proj + (size_t)CONV_ROW(pos + 1) * NINP + c0;
                nb[0] = *(const GAS v4u*)(pr + PC_B); nb[1] = *(const GAS v4u*)(pr + PC_B + 8); nc[0] = *(const GAS v4u*)(pr + PC_C); nc[1] = *(const GAS v4u*)(pr + PC_C + 8); nh[0] = *(const GAS v4u*)(pr + PC_H); nh[1] = *(const GAS v4u*)(pr + PC_H + 8); }
#pragma unroll
            for (int i = 0; i < 16; ++i) u0[i] *= t[i];
            float ss = 0.f;
#pragma unroll
            for (int i = 0; i < 4; ++i) { const f32x4 w0 = *(const GAS f32x4*)(cw + c0 + 4 * i), w1 = *(const GAS f32x4*)(cw + DCONV + c0 + 4 * i), w2 = *(const GAS f32x4*)(cw + 2 * DCONV + c0 + 4 * i);
#pragma unroll
                for (int e = 0; e < 4; ++e) { const int j = 4 * i + e; y[j] = cb[j] * (w0[e] * u2[j] + w1[e] * u1[j] + w2[e] * u0[j]); ss += y[j] * y[j]; } }
            ss += __shfl_xor(ss, 1); ss += __shfl_xor(ss, 2); ss += __shfl_xor(ss, 4);
            const float rs = 1.0f / sqrtf(ss * (1.0f / 128.0f) + EPS);
#pragma unroll
            for (int i = 0; i < 4; ++i) { const f32x4 g4 = *(const GAS f32x4*)(cg + c0 + 4 * i); w[4 * i] = g4[0]; w[4 * i + 1] = g4[1]; w[4 * i + 2] = g4[2]; w[4 * i + 3] = g4[3]; }
            v4u o0, o1;
            o0.x = pk2(y[0] * rs * w[0], y[1] * rs * w[1]); o0.y = pk2(y[2] * rs * w[2], y[3] * rs * w[3]); o0.z = pk2(y[4] * rs * w[4], y[5] * rs * w[5]); o0.w = pk2(y[6] * rs * w[6], y[7] * rs * w[7]);
            o1.x = pk2(y[8] * rs * w[8], y[9] * rs * w[9]); o1.y = pk2(y[10] * rs * w[10], y[11] * rs * w[11]); o1.z = pk2(y[12] * rs * w[12], y[13] * rs * w[13]); o1.w = pk2(y[14] * rs * w[14], y[15] * rs * w[15]);
            GAS bf16* yo = ymix + (size_t)row * D + c0; ((GAS v4u*)yo)[0] = o0; ((GAS v4u*)yo)[1] = o1;
            GAS float* uo = nullptr;
            if (isp) { if (pos >= 2062) uo = out + O_CP + ((size_t)(l * 4 + sq) * 2 + (pos - 2062)) * DCONV; }
            else if (pos >= 6) uo = out + O_CS + ((size_t)(l * 128 + sq) * 2 + (pos - 6)) * DCONV;
            if (uo) {
#pragma unroll
                for (int i = 0; i < 4; ++i) ((GAS f32x4*)(uo + c0))[i] = (f32x4){u0[4 * i], u0[4 * i + 1], u0[4 * i + 2], u0[4 * i + 3]}; }
#pragma unroll
            for (int i = 0; i < 16; ++i) { u2[i] = u1[i]; u1[i] = u0[i]; }
        }
#undef CONV_ROW
    }
}

typedef short bf16x8 __attribute__((ext_vector_type(8)));
DI unsigned pkbf(float lo, float hi) { f32x2 v = {lo, hi}; bf16x2_t r = __builtin_convertvector(v, bf16x2_t); return __builtin_bit_cast(unsigned, r); }
DI bf16x8 mk8(v2u lo, v2u hi) { v4u t = {lo.x, lo.y, hi.x, hi.y}; return __builtin_bit_cast(bf16x8, t); }
DI void tr2(unsigned a0, unsigned a1, v2u& r0, v2u& r1) {
    asm volatile("ds_read_b64_tr_b16 %0, %2\n\tds_read_b64_tr_b16 %1, %3\n\ts_waitcnt lgkmcnt(0)" : "=&v"(r0), "=&v"(r1) : "v"(a0), "v"(a1) : "memory");
}
#define LBAR() do { asm volatile("s_waitcnt lgkmcnt(0)" ::: "memory"); __builtin_amdgcn_s_barrier(); asm volatile("" ::: "memory"); } while (0)
constexpr int GS_QK = 272, GS_V = 528, GS_P = 144, GS_O = 1040;
constexpr int GL_QS = 0, GL_KD = 17408, GL_KL = 34816, GL_V = 52224, GL_PL = 86016, GL_FL = 95232, GL_GT = 99328, GL_EBL = 103424, GL_OL = 0;
DI int chunk_row(bool is_prompt, int bidx, int c, int t) {
    if (is_prompt) { if (c == 0) return t >= 48 ? R_META + 16 * bidx + (t - 48) : -1; return 2048 * bidx + 64 * (c - 1) + t; }
    return t >= 56 ? R_SAMPLE + 8 * bidx + (t - 56) : -1;
}
DI float logsig16(float x) { return (fminf(x, 0.f) - __logf(1.0f + __expf(-fabsf(x)))) * (1.0f / 16.0f); }

#define GLA_LANES() int tid = w * 64 + fresh_lane(); asm volatile("" : "+v"(tid)); const int lane = tid & 63, r = lane & 15, q = lane >> 4, dp = lane, c8 = tid & 31; (void)r; (void)q; (void)dp; (void)c8;
DI void gla_out_stage(LAS unsigned char* lds, const GAS bf16* proj, GAS bf16* ymix, const GAS float* __restrict__ gg, int hd, bool is_prompt, int bidx, int c, const int w) {
    GLA_LANES();
    const f32x4 ggA = *(const GAS f32x4*)(gg + 8 * c8), ggB = *(const GAS f32x4*)(gg + 8 * c8 + 4);
    v4u gw4[4]; int rows[4];
#pragma unroll
    for (int ps = 0; ps < 4; ++ps) { rows[ps] = chunk_row(is_prompt, bidx, c, 16 * ps + (tid >> 5)); const int rc = rows[ps] < 0 ? 0 : rows[ps];
        gw4[ps] = *(const GAS v4u*)(proj + (size_t)rc * NINP + PC_GO + 256 * hd + 8 * c8); }
#pragma unroll
    for (int ps = 0; ps < 4; ++ps) { const int t = 16 * ps + (tid >> 5); const LAS unsigned char* op = lds + GL_OL + t * GS_O + 32 * c8;
        const f32x4 oa = *(const LAS f32x4*)op, ob = *(const LAS f32x4*)(op + 16);
        float ss = (oa[0] * oa[0] + oa[1] * oa[1]) + (oa[2] * oa[2] + oa[3] * oa[3]) + (ob[0] * ob[0] + ob[1] * ob[1]) + (ob[2] * ob[2] + ob[3] * ob[3]);
        ss += __shfl_xor(ss, 1); ss += __shfl_xor(ss, 2); ss += __shfl_xor(ss, 4); ss += __shfl_xor(ss, 8); ss += __shfl_xor(ss, 16);
        const float rs = 1.0f / sqrtf(ss * (1.0f / 256.0f) + EPS);
        if (rows[ps] >= 0) { const v4u g4 = gw4[ps];
            const float gv[8] = {bflo(g4.x), bfhi(g4.x), bflo(g4.y), bfhi(g4.y), bflo(g4.z), bfhi(g4.z), bflo(g4.w), bfhi(g4.w)}; float y[8];
#pragma unroll
            for (int e = 0; e < 4; ++e) { y[e] = oa[e] * rs * ggA[e] * (gv[e] / (1.0f + __expf(-gv[e]))); y[4 + e] = ob[e] * rs * ggB[e] * (gv[4 + e] / (1.0f + __expf(-gv[4 + e]))); }
            *(GAS v4u*)(ymix + (size_t)rows[ps] * D + DCONV + 256 * hd + 8 * c8) = (v4u){pkbf(y[0], y[1]), pkbf(y[2], y[3]), pkbf(y[4], y[5]), pkbf(y[6], y[7])}; } }
}

DI void gla_sample_item(LAS unsigned char* lds, const GAS bf16* proj, GAS bf16* ymix, const GAS float* __restrict__ fw2, const GAS float* __restrict__ fb, const GAS float* __restrict__ gg,
                        int hd, int sb, const GAS float* S_in, GAS float* S_out, const int w) {
    const int lane = fresh_lane();
    LAS float* L_Q = (LAS float*)(lds + 0);
    LAS float* L_K = (LAS float*)(lds + 4096);
    LAS float* L_DEC = (LAS float*)(lds + 8192);
    LAS float* L_V = (LAS float*)(lds + 12288);
    LAS float* L_PART = (LAS float*)(lds + 20480);
    const int row = R_SAMPLE + sb * 8 + w;
    const GAS bf16* pr = proj + (size_t)row * NINP;
    f32x4 S[16];
#pragma unroll
    for (int i = 0; i < 16; ++i) S[i] = __builtin_nontemporal_load((const GAS f32x4*)(S_in + (size_t)(16 * w + i) * GDV) + lane);
    const v2u gw2 = *(const GAS v2u*)(pr + PC_GO + 256 * hd + 4 * lane);
    const f32x4 ggv = ((const GAS f32x4*)gg)[lane];
    {
        const v4u f0 = *(const GAS v4u*)(pr + PC_FL), f1 = *(const GAS v4u*)(pr + PC_FL + 8);
        const float fl[16] = {bflo(f0.x), bfhi(f0.x), bflo(f0.y), bfhi(f0.y), bflo(f0.z), bfhi(f0.z), bflo(f0.w), bfhi(f0.w), bflo(f1.x), bfhi(f1.x), bflo(f1.y), bfhi(f1.y), bflo(f1.z), bfhi(f1.z), bflo(f1.w), bfhi(f1.w)};
        const f32x2 fbv = *(const GAS f32x2*)(fb + 128 * hd + 2 * lane);
        float x0 = fbv[0], x1 = fbv[1];
#pragma unroll
        for (int r = 0; r < 16; ++r) { const f32x2 ww = *(const GAS f32x2*)(fw2 + r * 512 + 128 * hd + 2 * lane); x0 += fl[r] * ww[0]; x1 += fl[r] * ww[1]; }
        const unsigned qw = *(const GAS unsigned*)(pr + PC_Q + 128 * hd + 2 * lane), kw = *(const GAS unsigned*)(pr + PC_K + 128 * hd + 2 * lane);
        const float qs = 0.08838834764831845f;
        *(LAS f32x2*)(L_Q + w * 128 + 2 * lane) = (f32x2){bflo(qw) * qs, bfhi(qw) * qs};
        *(LAS f32x2*)(L_K + w * 128 + 2 * lane) = (f32x2){bflo(kw), bfhi(kw)};
        *(LAS f32x2*)(L_DEC + w * 128 + 2 * lane) = (f32x2){__expf(logsig16(x0)), __expf(logsig16(x1))};
        const v2u vw = *(const GAS v2u*)(pr + PC_V + 256 * hd + 4 * lane);
        *(LAS f32x4*)(L_V + w * 256 + 4 * lane) = (f32x4){bflo(vw.x), bfhi(vw.x), bflo(vw.y), bfhi(vw.y)};
    }
    LBAR();
#pragma unroll 2
    for (int t = 0; t < 8; ++t) {
        const f32x4 vv = *(const LAS f32x4*)(L_V + t * 256 + 4 * lane);
        f32x4 po = (f32x4){0.f, 0.f, 0.f, 0.f};
#pragma unroll
        for (int i4 = 0; i4 < 4; ++i4) {
            const f32x4 dq = *(const LAS f32x4*)(L_DEC + t * 128 + 16 * w + 4 * i4), kq = *(const LAS f32x4*)(L_K + t * 128 + 16 * w + 4 * i4), qq = *(const LAS f32x4*)(L_Q + t * 128 + 16 * w + 4 * i4);
#pragma unroll
            for (int e = 0; e < 4; ++e) { const int i = 4 * i4 + e; S[i] = S[i] * dq[e] + vv * kq[e]; po += S[i] * qq[e]; }
        }
        *(LAS f32x4*)(L_PART + (t * 8 + w) * 256 + 4 * lane) = po;
    }
#pragma unroll
    for (int i = 0; i < 16; ++i) __builtin_nontemporal_store(S[i], (GAS f32x4*)(S_out + (size_t)(16 * w + i) * GDV) + lane);
    LBAR();
    {
        f32x4 o = (f32x4){0.f, 0.f, 0.f, 0.f};
#pragma unroll
        for (int ww = 0; ww < 8; ++ww) o += *(const LAS f32x4*)(L_PART + (w * 8 + ww) * 256 + 4 * lane);
        const float ss = wave_sum((o[0] * o[0] + o[1] * o[1]) + (o[2] * o[2] + o[3] * o[3]));
        const float rs = 1.0f / sqrtf(ss * (1.0f / 256.0f) + EPS);
        const float gv[4] = {bflo(gw2.x), bfhi(gw2.x), bflo(gw2.y), bfhi(gw2.y)}; float y[4];
#pragma unroll
        for (int e = 0; e < 4; ++e) y[e] = o[e] * rs * ggv[e] * (gv[e] / (1.0f + __expf(-gv[e])));
        *(GAS v2u*)(ymix + (size_t)row * D + DCONV + 256 * hd + 4 * lane) = (v2u){pkbf(y[0], y[1]), pkbf(y[2], y[3])};
    }
    LBAR();
}

DI void gla_item_mfma(LAS unsigned char* lds, const GAS bf16* proj, GAS bf16* ymix, const GAS float* __restrict__ fw2, const GAS float* __restrict__ fb, const GAS float* __restrict__ gg,
                      int hd, bool is_prompt, int bidx, int c0, const GAS float* S_in, GAS float* S_out, const int w,
                      GAS bf16* gqs, GAS bf16* gpl, GAS float* gebl, GAS float* gu) {
    const int tg = w;
#define GLA_LOAD_QK(c, DP) do { \
        _Pragma("unroll") for (int i = 0; i < 8; ++i) { const int row_ = chunk_row(is_prompt, bidx, (c), 8 * tg + i); const int rc_ = row_ < 0 ? 0 : row_; \
            const GAS bf16* p_ = proj + (size_t)rc_ * NINP + 128 * hd + 2 * (DP); const unsigned qv_ = *(const GAS unsigned*)(p_ + PC_Q), kv_ = *(const GAS unsigned*)(p_ + PC_K); qw[i] = row_ < 0 ? 0u : qv_; kw[i] = row_ < 0 ? 0u : kv_; } \
    } while (0)
#define GLA_LOAD_V(c) do { \
        _Pragma("unroll") for (int i = 0; i < 4; ++i) { const int row_ = chunk_row(is_prompt, bidx, (c), (tid >> 5) + 16 * i); const int rc_ = row_ < 0 ? 0 : row_; \
            const v4u vv_ = *(const GAS v4u*)(proj + (size_t)rc_ * NINP + PC_V + 256 * hd + 8 * c8); vr[i] = row_ < 0 ? (v4u){0u, 0u, 0u, 0u} : vv_; } \
        { const int row_ = chunk_row(is_prompt, bidx, (c), (tid >> 1) & 63); const int rc_ = row_ < 0 ? 0 : row_; const v4u ff_ = *(const GAS v4u*)(proj + (size_t)rc_ * NINP + PC_FL + 8 * (tid & 1)); flr = row_ < 0 ? (v4u){0u, 0u, 0u, 0u} : ff_; } \
    } while (0)
    {
        const int c = c0;
        const int tmin = is_prompt ? (c == 0 ? 48 : 0) : 56;
        {
            GLA_LANES();
            v4u vr[4]; v4u flr;
            GLA_LOAD_V(c);
#pragma unroll
            for (int i = 0; i < 4; ++i) *(LAS v4u*)(lds + GL_V + ((tid >> 5) + 16 * i) * GS_V + 16 * c8) = vr[i];
            if (tid < 128) { LAS float* f = (LAS float*)(lds + GL_FL) + (tid >> 1) * 16 + 8 * (tid & 1);
                *(LAS f32x4*)f = (f32x4){bflo(flr.x), bfhi(flr.x), bflo(flr.y), bfhi(flr.y)}; *(LAS f32x4*)(f + 4) = (f32x4){bflo(flr.z), bfhi(flr.z), bflo(flr.w), bfhi(flr.w)}; }
        }
        LBAR();
        {
            const int dpa = fresh_lane();
            const f32x2 fbv = *(const GAS f32x2*)(fb + 128 * hd + 2 * dpa);
            unsigned qw[8], kw[8];
            GLA_LOAD_QK(c, dpa);
            float c0[8], c1[8]; float run0 = 0.f, run1 = 0.f;
#pragma unroll
            for (int i = 0; i < 8; ++i) { c0[i] = fbv[0]; c1[i] = fbv[1]; }
#pragma unroll
            for (int j = 0; j < 4; ++j) { f32x2 fwj[4];
#pragma unroll
                for (int e = 0; e < 4; ++e) fwj[e] = *(const GAS f32x2*)(fw2 + (4 * j + e) * 512 + 128 * hd + 2 * dpa);
#pragma unroll
                for (int i = 0; i < 8; ++i) { const f32x4 f = ((const LAS f32x4*)(lds + GL_FL))[(8 * tg + i) * 4 + j];
#pragma unroll
                    for (int e = 0; e < 4; ++e) { c0[i] += f[e] * fwj[e][0]; c1[i] += f[e] * fwj[e][1]; } }
                __builtin_amdgcn_sched_barrier(0); }
#pragma unroll
            for (int i = 0; i < 8; ++i) { const bool valid = (8 * tg + i) >= tmin;
                run0 += valid ? logsig16(c0[i]) : 0.f; run1 += valid ? logsig16(c1[i]) : 0.f; c0[i] = run0; c1[i] = run1; if (i & 1) __builtin_amdgcn_sched_barrier(0); }
            { const int dp2 = fresh_lane(); *(LAS f32x2*)(lds + GL_GT + (tg * 128 + 2 * dp2) * 4) = (f32x2){run0, run1}; }
            LBAR();
            const int dp = fresh_lane();
            float off0 = 0.f, off1 = 0.f, tot0 = 0.f, tot1 = 0.f;
#pragma unroll
            for (int g8 = 0; g8 < 8; ++g8) { const f32x2 v = *(const LAS f32x2*)(lds + GL_GT + (g8 * 128 + 2 * dp) * 4); tot0 += v[0]; tot1 += v[1]; if (g8 < tg) { off0 += v[0]; off1 += v[1]; } }
#pragma unroll
            for (int i = 0; i < 8; ++i) { const int t = 8 * tg + i; const float b0 = off0 + c0[i], b1 = off1 + c1[i];
                const float eb0 = __expf(b0), eb1 = __expf(b1), en0 = __expf(-b0), en1 = __expf(-b1), el0 = __expf(tot0 - b0), el1 = __expf(tot1 - b1);
                const float q0 = bflo(qw[i]) * 0.08838834764831845f, q1 = bfhi(qw[i]) * 0.08838834764831845f, k0 = bflo(kw[i]), k1 = bfhi(kw[i]);
                *(LAS unsigned*)(lds + GL_QS + t * GS_QK + 4 * dp) = pkbf(q0 * eb0, q1 * eb1);
                *(LAS unsigned*)(lds + GL_KD + t * GS_QK + 4 * dp) = pkbf(k0 * en0, k1 * en1);
                *(LAS unsigned*)(lds + GL_KL + t * GS_QK + 4 * dp) = pkbf(k0 * el0, k1 * el1); if (i & 1) __builtin_amdgcn_sched_barrier(0); }
            if (tg == 0) *(LAS f32x2*)(lds + GL_EBL + 8 * dp) = (f32x2){__expf(tot0), __expf(tot1)};
        }
        LBAR();
        {
            GLA_LANES();
#pragma unroll
            for (int j2 = 0; j2 < 2; ++j2) { const int idx = 2 * w + j2, st = idx >> 2, tt = idx & 3;
                f32x4 acc = (f32x4){0.f, 0.f, 0.f, 0.f};
                if (st <= tt) {
#pragma unroll
                    for (int ks = 0; ks < 4; ++ks) { const bf16x8 a = *(const LAS bf16x8*)(lds + GL_KD + (16 * st + r) * GS_QK + (32 * ks + 8 * q) * 2), b = *(const LAS bf16x8*)(lds + GL_QS + (16 * tt + r) * GS_QK + (32 * ks + 8 * q) * 2);
                        acc = __builtin_amdgcn_mfma_f32_16x16x32_bf16(a, b, acc, 0, 0, 0); }
                }
                const int tq = 16 * tt + r, s0 = 16 * st + 4 * q;
                const float p0 = (s0 + 0 <= tq) ? acc[0] : 0.f, p1 = (s0 + 1 <= tq) ? acc[1] : 0.f, p2 = (s0 + 2 <= tq) ? acc[2] : 0.f, p3 = (s0 + 3 <= tq) ? acc[3] : 0.f;
                *(LAS v2u*)(lds + GL_PL + tq * GS_P + s0 * 2) = (v2u){pkbf(p0, p1), pkbf(p2, p3)}; }
        }
        LBAR();
        if (is_prompt) {
            GLA_LANES();
            const unsigned lbase = (unsigned)(uintptr_t)lds;
            bf16x8 Vf[2][2];
#pragma unroll
            for (int ks = 0; ks < 2; ++ks)
#pragma unroll
                for (int vt = 0; vt < 2; ++vt) { const unsigned a0 = lbase + GL_V + (32 * ks + 8 * q + (r >> 2)) * GS_V + (32 * w + 16 * vt + 4 * (r & 3)) * 2; v2u lo, hi; tr2(a0, a0 + 4 * GS_V, lo, hi); Vf[ks][vt] = mk8(lo, hi); }
#pragma unroll
            for (int dt = 0; dt < 8; ++dt) { f32x4 C0 = (f32x4){0.f, 0.f, 0.f, 0.f}, C1 = (f32x4){0.f, 0.f, 0.f, 0.f};
#pragma unroll
                for (int ks = 0; ks < 2; ++ks) { const unsigned a0 = lbase + GL_KL + (32 * ks + 8 * q + (r >> 2)) * GS_QK + (16 * dt + 4 * (r & 3)) * 2; v2u lo, hi; tr2(a0, a0 + 4 * GS_QK, lo, hi); const bf16x8 kl = mk8(lo, hi);
                    C0 = __builtin_amdgcn_mfma_f32_16x16x32_bf16(Vf[ks][0], kl, C0, 0, 0, 0); C1 = __builtin_amdgcn_mfma_f32_16x16x32_bf16(Vf[ks][1], kl, C1, 0, 0, 0); }
                GAS bf16* up = (GAS bf16*)gu + (size_t)(16 * dt + r) * GDV + 32 * w + 4 * q; *(GAS v2u*)up = (v2u){pkbf(C0[0], C0[1]), pkbf(C0[2], C0[3])}; *(GAS v2u*)(up + 16) = (v2u){pkbf(C1[0], C1[1]), pkbf(C1[2], C1[3])}; __builtin_amdgcn_sched_barrier(0); }
            { const int row = tid >> 3, ch = tid & 7;
              const v4u a = *(const LAS v4u*)(lds + GL_QS + row * GS_QK + 32 * ch), b2 = *(const LAS v4u*)(lds + GL_QS + row * GS_QK + 32 * ch + 16);
              *(GAS v4u*)(gqs + row * 128 + 16 * ch) = a; *(GAS v4u*)(gqs + row * 128 + 16 * ch + 8) = b2;
              *(GAS v4u*)(gpl + row * 64 + 8 * ch) = *(const LAS v4u*)(lds + GL_PL + row * GS_P + 16 * ch);
              if (tid < 128) gebl[tid] = *(const LAS float*)(lds + GL_EBL + 4 * tid); }
            LBAR();
            return;
        }
        f32x4 O[4][2]; f32x4 Sacc[8][2];
        {
            GLA_LANES();
            { const GAS float* sp = S_in + (size_t)(4 * q) * GDV + 32 * w + r;
#pragma unroll
              for (int dt = 0; dt < 8; ++dt)
#pragma unroll
                  for (int vt = 0; vt < 2; ++vt)
#pragma unroll
                      for (int i = 0; i < 4; ++i) Sacc[dt][vt][i] = sp[(16 * dt + i) * GDV + 16 * vt]; }
            const unsigned lbase = (unsigned)(uintptr_t)lds;
#pragma unroll
            for (int tt = 0; tt < 4; ++tt) { O[tt][0] = (f32x4){0.f, 0.f, 0.f, 0.f}; O[tt][1] = (f32x4){0.f, 0.f, 0.f, 0.f}; }
#pragma unroll
            for (int ks = 0; ks < 4; ++ks) {
                bf16x8 Sb[2];
#pragma unroll
                for (int vt = 0; vt < 2; ++vt) { const f32x4 lo = Sacc[2 * ks][vt], hi = Sacc[2 * ks + 1][vt]; Sb[vt] = __builtin_bit_cast(bf16x8, (v4u){pkbf(lo[0], lo[1]), pkbf(lo[2], lo[3]), pkbf(hi[0], hi[1]), pkbf(hi[2], hi[3])}); }
#pragma unroll
                for (int tt = 0; tt < 4; ++tt) { const LAS unsigned char* qp = lds + GL_QS + (16 * tt + r) * GS_QK + (32 * ks + 4 * q) * 2;
                    const bf16x8 a = mk8(*(const LAS v2u*)qp, *(const LAS v2u*)(qp + 32));
                    O[tt][0] = __builtin_amdgcn_mfma_f32_16x16x32_bf16(a, Sb[0], O[tt][0], 0, 0, 0); O[tt][1] = __builtin_amdgcn_mfma_f32_16x16x32_bf16(a, Sb[1], O[tt][1], 0, 0, 0); }
                __builtin_amdgcn_sched_barrier(0);
            }
            bf16x8 Vf[2][2];
#pragma unroll
            for (int ks = 0; ks < 2; ++ks)
#pragma unroll
                for (int vt = 0; vt < 2; ++vt) { const unsigned a0 = lbase + GL_V + (32 * ks + 8 * q + (r >> 2)) * GS_V + (32 * w + 16 * vt + 4 * (r & 3)) * 2; v2u lo, hi; tr2(a0, a0 + 4 * GS_V, lo, hi); Vf[ks][vt] = mk8(lo, hi); }
#pragma unroll
            for (int ks = 0; ks < 2; ++ks)
#pragma unroll
                for (int tt = 0; tt < 4; ++tt) { const bf16x8 a = *(const LAS bf16x8*)(lds + GL_PL + (16 * tt + r) * GS_P + (32 * ks + 8 * q) * 2);
                    O[tt][0] = __builtin_amdgcn_mfma_f32_16x16x32_bf16(a, Vf[ks][0], O[tt][0], 0, 0, 0); O[tt][1] = __builtin_amdgcn_mfma_f32_16x16x32_bf16(a, Vf[ks][1], O[tt][1], 0, 0, 0); }
            __builtin_amdgcn_sched_barrier(0);
#pragma unroll
            for (int dt = 0; dt < 8; ++dt) { const f32x4 e4 = *(const LAS f32x4*)(lds + GL_EBL + (16 * dt + 4 * q) * 4);
                f32x4 C0 = Sacc[dt][0] * e4, C1 = Sacc[dt][1] * e4;
#pragma unroll
                for (int ks = 0; ks < 2; ++ks) { const unsigned a0 = lbase + GL_KL + (32 * ks + 8 * q + (r >> 2)) * GS_QK + (16 * dt + 4 * (r & 3)) * 2; v2u lo, hi; tr2(a0, a0 + 4 * GS_QK, lo, hi); const bf16x8 a = mk8(lo, hi);
                    C0 = __builtin_amdgcn_mfma_f32_16x16x32_bf16(a, Vf[ks][0], C0, 0, 0, 0); C1 = __builtin_amdgcn_mfma_f32_16x16x32_bf16(a, Vf[ks][1], C1, 0, 0, 0); }
                GAS float* so = S_out + (size_t)(16 * dt + 4 * q) * GDV + 32 * w + r;
#pragma unroll
                for (int i = 0; i < 4; ++i) { so[i * GDV] = C0[i]; so[i * GDV + 16] = C1[i]; }
                __builtin_amdgcn_sched_barrier(0); }
        }
        LBAR();
        {   GLA_LANES();
#pragma unroll
            for (int tt = 0; tt < 4; ++tt)
#pragma unroll
                for (int vt = 0; vt < 2; ++vt)
#pragma unroll
                    for (int i = 0; i < 4; ++i) *(LAS float*)(lds + GL_OL + (16 * tt + 4 * q + i) * GS_O + (32 * w + 16 * vt + r) * 4) = O[tt][vt][i];
        }
        LBAR();
        gla_out_stage(lds, proj, ymix, gg, hd, is_prompt, bidx, c, w);
        LBAR();
    }
#undef GLA_LOAD_QK
#undef GLA_LOAD_V
}

DI void gla_scan_phase(const GAS float* gu, const GAS float* gebl, GAS bf16* gs, GAS float* out_state, int gtid, int nthreads) {
    for (int e = gtid; e < 16 * 8192; e += nthreads) {
        const int bh = e >> 13, rem = e & 8191, d = rem >> 6, v = (rem & 63) * 4;
        f32x4 S = (f32x4){0.f, 0.f, 0.f, 0.f};
#pragma nounroll
        for (int c3 = 0; c3 < 33; c3 += 11) {
            f32x4 u[11]; float eb[11];
#pragma unroll
            for (int j = 0; j < 11; ++j) { const size_t idx = (size_t)bh * 33 + c3 + j; const v2u w2 = __builtin_nontemporal_load((const GAS v2u*)((const GAS bf16*)gu + (idx * GDK + d) * GDV + v)); u[j] = (f32x4){bflo(w2.x), bfhi(w2.x), bflo(w2.y), bfhi(w2.y)}; eb[j] = gebl[idx * GDK + d]; }
#pragma unroll
            for (int j = 0; j < 11; ++j) { const size_t idx = (size_t)bh * 33 + c3 + j;
                *(GAS v2u*)(gs + (idx * GDK + d) * GDV + v) = (v2u){pkbf(S[0], S[1]), pkbf(S[2], S[3])};
                S = S * eb[j] + u[j]; }
        }
        *(GAS f32x4*)(out_state + ((size_t)bh * GDK + d) * GDV + v) = S;
    }
}

constexpr int CS_S = 0, CS_QS = 67584, CS_PL = 84992, CS_V = 94208;
DI void gla_passC_item(LAS unsigned char* lds, const GAS bf16* proj, GAS bf16* ymix, const GAS float* __restrict__ gg, int hd, int bidx, int c, const int w,
                       const GAS bf16* gqs, const GAS bf16* gpl, const GAS bf16* gs) {
    {   GLA_LANES();
        v4u sr[8], qr[2], pr, vr[4];
        if (c != 0) {
#pragma unroll
            for (int i = 0; i < 8; ++i) sr[i] = __builtin_nontemporal_load((const GAS v4u*)(gs + (size_t)((tid >> 5) + 16 * i) * GDV + 8 * c8));
        }
        { const int row = tid >> 3, ch = tid & 7; qr[0] = __builtin_nontemporal_load((const GAS v4u*)(gqs + row * 128 + 16 * ch)); qr[1] = __builtin_nontemporal_load((const GAS v4u*)(gqs + row * 128 + 16 * ch + 8)); pr = __builtin_nontemporal_load((const GAS v4u*)(gpl + row * 64 + 8 * ch)); }
#pragma unroll
        for (int i = 0; i < 4; ++i) { const int row_ = chunk_row(true, bidx, c, (tid >> 5) + 16 * i); const int rc_ = row_ < 0 ? 0 : row_;
            const v4u vv_ = *(const GAS v4u*)(proj + (size_t)rc_ * NINP + PC_V + 256 * hd + 8 * c8); vr[i] = row_ < 0 ? (v4u){0u, 0u, 0u, 0u} : vv_; }
        if (c != 0) {
#pragma unroll
            for (int i = 0; i < 8; ++i) *(LAS v4u*)(lds + CS_S + ((tid >> 5) + 16 * i) * GS_V + 16 * c8) = sr[i];
        }
        { const int row = tid >> 3, ch = tid & 7; *(LAS v4u*)(lds + CS_QS + row * GS_QK + 32 * ch) = qr[0]; *(LAS v4u*)(lds + CS_QS + row * GS_QK + 32 * ch + 16) = qr[1]; *(LAS v4u*)(lds + CS_PL + row * GS_P + 16 * ch) = pr; }
#pragma unroll
        for (int i = 0; i < 4; ++i) *(LAS v4u*)(lds + CS_V + ((tid >> 5) + 16 * i) * GS_V + 16 * c8) = vr[i];
    }
    LBAR();
    f32x4 O[4][2];
    {   GLA_LANES();
        const unsigned lbase = (unsigned)(uintptr_t)lds;
#pragma unroll
        for (int tt = 0; tt < 4; ++tt) { O[tt][0] = (f32x4){0.f, 0.f, 0.f, 0.f}; O[tt][1] = (f32x4){0.f, 0.f, 0.f, 0.f}; }
        if (c != 0) {
#pragma unroll
        for (int ks = 0; ks < 4; ++ks) {
            bf16x8 Sf[2];
#pragma unroll
            for (int vt = 0; vt < 2; ++vt) { const unsigned a0 = lbase + CS_S + (32 * ks + 8 * q + (r >> 2)) * GS_V + (32 * w + 16 * vt + 4 * (r & 3)) * 2; v2u lo, hi; tr2(a0, a0 + 4 * GS_V, lo, hi); Sf[vt] = mk8(lo, hi); }
#pragma unroll
            for (int tt = 0; tt < 4; ++tt) { const bf16x8 a = *(const LAS bf16x8*)(lds + CS_QS + (16 * tt + r) * GS_QK + (32 * ks + 8 * q) * 2);
                O[tt][0] = __builtin_amdgcn_mfma_f32_16x16x32_bf16(a, Sf[0], O[tt][0], 0, 0, 0); O[tt][1] = __builtin_amdgcn_mfma_f32_16x16x32_bf16(a, Sf[1], O[tt][1], 0, 0, 0); }
            __builtin_amdgcn_sched_barrier(0);
        }
        }
#pragma unroll
        for (int ks = 0; ks < 2; ++ks) {
            bf16x8 Vf[2];
#pragma unroll
            for (int vt = 0; vt < 2; ++vt) { const unsigned a0 = lbase + CS_V + (32 * ks + 8 * q + (r >> 2)) * GS_V + (32 * w + 16 * vt + 4 * (r & 3)) * 2; v2u lo, hi; tr2(a0, a0 + 4 * GS_V, lo, hi); Vf[vt] = mk8(lo, hi); }
#pragma unroll
            for (int tt = 0; tt < 4; ++tt) { const bf16x8 a = *(const LAS bf16x8*)(lds + CS_PL + (16 * tt + r) * GS_P + (32 * ks + 8 * q) * 2);
                O[tt][0] = __builtin_amdgcn_mfma_f32_16x16x32_bf16(a, Vf[0], O[tt][0], 0, 0, 0); O[tt][1] = __builtin_amdgcn_mfma_f32_16x16x32_bf16(a, Vf[1], O[tt][1], 0, 0, 0); }
            __builtin_amdgcn_sched_barrier(0);
        }
    }
    LBAR();
    {   GLA_LANES();
#pragma unroll
        for (int tt = 0; tt < 4; ++tt)
#pragma unroll
            for (int vt = 0; vt < 2; ++vt)
#pragma unroll
                for (int i = 0; i < 4; ++i) *(LAS float*)(lds + GL_OL + (16 * tt + 4 * q + i) * GS_O + (32 * w + 16 * vt + r) * 4) = O[tt][vt][i];
    }
    LBAR();
    gla_out_stage(lds, proj, ymix, gg, hd, true, bidx, c, w);
    LBAR();
}
#undef GLA_LANES

struct Args { const float* in[20]; float* out; unsigned char* ws; int ph_lo, ph_hi; };
constexpr int N_PHASES = 1 + 12 * DEPTH;

__global__ void __launch_bounds__(NWAVES * 64, 2) mk_fwd(Args args) {
    extern __shared__ __attribute__((aligned(16))) unsigned char lds_raw[];
    LAS unsigned char* lds = (LAS unsigned char*)lds_raw;
    volatile LAS unsigned* MISC = (volatile LAS unsigned*)(lds + MISC_OFF);
    const int tid = threadIdx.x, lane = tid & 63, wave = __builtin_amdgcn_readfirstlane(tid >> 6);
    const int G = gridDim.x, bx = blockIdx.x;
    const int vcu = (G % 8 == 0) ? (bx % 8) * (G / 8) + bx / 8 : bx;
    const int gw = vcu * NWAVES + wave, NGW = G * NWAVES;
    unsigned char* ws = args.ws;
    unsigned* ctl = (unsigned*)(ws + WS_CTL);
    bf16* hbuf = (bf16*)(ws + WS_H); float* xn = (float*)(ws + WS_XN); bf16* act = (bf16*)(ws + WS_ACT); bf16* proj = (bf16*)(ws + WS_PROJ); bf16* ymix = (bf16*)(ws + WS_YMIX);
    if (tid < 32) MISC[tid] = 0u;
    __syncthreads();
    XcdBarrier bar; bar.bar = ctl + CW_BAR; bar.x = 0; bar.st = nullptr;
    if (MK_N_LAUNCHES == 1) bar = xcd_barrier_post(ctl + CW_BAR, MISC + 8, wave);
    const int lo = args.ph_lo, hi = args.ph_hi;
#define IN(k) (lo <= (k) && (k) < hi)
#define SEAM(k) do { if (MK_N_LAUNCHES == 1 && IN((k) + 1)) xcd_barrier(bar, wave); } while (0)

#define CONVERT_RANGE(ib, ie, widx, wstride) convert_range(args.in[6], args.in[7], args.in[9], args.in[15], args.in[17], args.in[18], args.in[5], args.in[8], args.in[16], args.ws + WS_W, (ib), (ie), (widx), (wstride), (LAS float*)(lds + wave * 16640), fresh_lane())
#define CONVERT_IN_TAIL(nbusy, ib, ie) do { int fi_ = (nbusy), ni_ = G_ - fi_; if (ni_ <= 0) { fi_ = 0; ni_ = G_; } \
        const int gb_ = I_GU + l_p * I_LAYER + (ib), ge_ = (I_GU + l_p * I_LAYER + (ie)) < DEPTH * I_LAYER ? (I_GU + l_p * I_LAYER + (ie)) : DEPTH * I_LAYER; \
        if (bx_ >= fi_ && gb_ < ge_) CONVERT_RANGE(gb_, ge_, (bx_ - fi_) * NWAVES + wave, ni_ * NWAVES); } while (0)
    constexpr int CV0 = 0, CV1 = 5914, CV2 = 8294, CV3 = 11864, CV4 = 12730, CV5 = 18644, CV6 = I_LAYER;
    static_assert(I_GU + CV1 >= I_GU + I_DN && I_GU + CV2 >= I_GU + I_DN + I_IN && I_GU + CV3 >= I_GU + I_DN + I_IN + I_OUT && I_GU + CV4 >= 2 * I_GU + I_DN + I_IN + I_OUT && I_GU + CV5 >= I_LAYER, "conversion runs ahead of consumption");
    if (IN(0)) {
        CONVERT_RANGE(0, I_GU, gw, NGW);
        for (int i = gw * 64 + lane; i < DEPTH * (NINP - NIN) * (D / 8); i += NGW * 64) { const int l = i / ((NINP - NIN) * (D / 8)), r = i % ((NINP - NIN) * (D / 8));
            ((v4u*)(ws + WS_W + (size_t)l * W_LAYER + WO_IN + (size_t)NIN * D * 2))[r] = (v4u){0u, 0u, 0u, 0u}; }
        norm_phase<1>(args.in[0], args.in[1], args.in[4], hbuf, args.in[5], xn, nullptr, gw, NGW, lane, nullptr, 0.f, D, G, lds, tid);
        SEAM(0);
    }

#define PH_LOCALS() int tid_p = wave * 64 + fresh_lane(); asm volatile("" : "+v"(tid_p)); const int lane_p = tid_p & 63; int gw_p = gw, ngw_p = NGW, G_ = gridDim.x, bx_ = blockIdx.x, vcu_p = vcu, l_p = l; \
        unsigned char* ws_p = ws; asm volatile("" : "+s"(gw_p), "+s"(ngw_p), "+s"(G_), "+s"(bx_), "+s"(vcu_p), "+s"(l_p), "+s"(ws_p)); \
        unsigned char* wl = ws_p + WS_W + (size_t)l_p * W_LAYER; bf16* hbuf_p = (bf16*)(ws_p + WS_H); float* xn_p = (float*)(ws_p + WS_XN); bf16* act_p = (bf16*)(ws_p + WS_ACT); bf16* proj_p = (bf16*)(ws_p + WS_PROJ); bf16* ymix_p = (bf16*)(ws_p + WS_YMIX); \
        (void)lane_p; (void)gw_p; (void)ngw_p; (void)G_; (void)bx_; (void)vcu_p; (void)wl; (void)hbuf_p; (void)xn_p; (void)act_p; (void)proj_p; (void)ymix_p;
#pragma nounroll
    for (int l = 0; l < DEPTH; ++l) {
        const int pb = 1 + 12 * l;
        if (IN(pb + 0)) { PH_LOCALS();
            pg8::Gemm g{hbuf_p, (const bf16*)(wl + WO_GU1), TP, NGU, D}; pg8::StaticOrder S; S.init(TP, NGU, D, G_, bx_);
            pg8::EpiSwiGLU E{act_p, FF, xn_p};
            pg8::gemm_phase<pg8::EpiSwiGLU, pg8::StaticOrder, true, true>(lds, g, S, E, wave);
            CONVERT_IN_TAIL(S.nwg % G_, CV0, CV1);
            SEAM(pb + 0);
        }
        if (IN(pb + 1)) { PH_LOCALS();
            pg8::Gemm g{act_p, (const bf16*)(wl + WO_DN1), TP, D, FF}; pg8::TailSplitOrder<TSP> S; S.init(TP, D, FF, G_, bx_);
            pg8::EpiResid E{hbuf_p, D, 0.5f, (float*)(ws_p + WS_SLAB)};
            pg8::gemm_phase<pg8::EpiResid, pg8::TailSplitOrder<TSP>, true, true>(lds, g, S, E, wave);
            CONVERT_IN_TAIL(S.ntail() * TSP, CV1, CV2);
            SEAM(pb + 1);
        }
        if (IN(pb + 2)) { PH_LOCALS(); norm_phase<0>(nullptr, nullptr, nullptr, hbuf_p, args.in[8] + (size_t)l_p * D, xn_p, nullptr, gw_p, ngw_p, lane_p, (const float*)(ws_p + WS_SLAB), 0.5f, FF, G_, lds, tid_p); SEAM(pb + 2); }
        if (IN(pb + 3)) { PH_LOCALS();
            pg8::Gemm g{hbuf_p, (const bf16*)(wl + WO_IN), TP, NINP, D}; pg8::StaticOrder S; S.init(TP, NINP, D, G_, bx_);
            pg8::EpiBf16 E{proj_p, NINP, xn_p};
            pg8::gemm_phase<pg8::EpiBf16, pg8::StaticOrder, true, true>(lds, g, S, E, wave);
            CONVERT_IN_TAIL(S.nwg % G_, CV2, CV3);
            SEAM(pb + 3);
        }
        if (IN(pb + 4)) { PH_LOCALS();
            if (G_ <= 32) conv_phase(proj_p, ymix_p, args.in[10] + (size_t)l_p * 3 * DCONV, args.in[11] + (size_t)l_p * DCONV, args.in[2] + (size_t)l_p * 128 * 2 * DCONV, args.out, l_p, gw_p, ngw_p, lane_p);
            else if (vcu_p >= 16) conv_phase(proj_p, ymix_p, args.in[10] + (size_t)l_p * 3 * DCONV, args.in[11] + (size_t)l_p * DCONV, args.in[2] + (size_t)l_p * 128 * 2 * DCONV, args.out, l_p, gw_p - 16 * NWAVES, ngw_p - 16 * NWAVES, lane_p);
            const GAS float* fw2 = (const GAS float*)args.in[12] + (size_t)l_p * GRANK * 512; const GAS float* fb = (const GAS float*)args.in[13] + (size_t)l_p * 512; const GAS float* gg = (const GAS float*)args.in[14] + (size_t)l_p * GDV;
            for (int it = vcu_p; it < 1040; it += G_) {
                const bool isp = it >= 512; const int j = isp ? it - 512 : it;
                const int bh = isp ? j / 33 : j, c = isp ? j - bh * 33 : 0, bi = bh >> 2, hd = bh & 3;
                if (!isp) gla_sample_item(lds, (const GAS bf16*)proj_p, (GAS bf16*)ymix_p, fw2, fb, gg, hd, bi, (const GAS float*)args.in[3] + ((size_t)l_p * 512 + bh) * GDK * GDV, (GAS float*)args.out + O_GS + ((size_t)l_p * 512 + bh) * GDK * GDV, wave);
                else gla_item_mfma(lds, (const GAS bf16*)proj_p, (GAS bf16*)ymix_p, fw2, fb, gg, hd, true, bi, c, nullptr, nullptr, wave,
                              (GAS bf16*)(ws_p + WS_GQS) + (size_t)j * 8192, (GAS bf16*)(ws_p + WS_GPL) + (size_t)j * 4096, (GAS float*)(ws_p + WS_GEBL) + (size_t)j * 128, (GAS float*)((GAS bf16*)(ws_p + WS_GU) + (size_t)j * 32768));
            }
            SEAM(pb + 4);
        }
        if (IN(pb + 5)) { PH_LOCALS();
            gla_scan_phase((const GAS float*)(ws_p + WS_GU), (const GAS float*)(ws_p + WS_GEBL), (GAS bf16*)(ws_p + WS_GS), (GAS float*)args.out + O_GP + (size_t)l_p * 16 * GDK * GDV, vcu_p * (NWAVES * 64) + tid_p, G_ * (NWAVES * 64));
            SEAM(pb + 5);
        }
        if (IN(pb + 6)) { PH_LOCALS();
            const GAS float* gg = (const GAS float*)args.in[14] + (size_t)l_p * GDV;
            for (int it = vcu_p; it < 528; it += G_) { const int bh = it < 512 ? (it >> 5) : it - 512, c = it < 512 ? 1 + (it & 31) : 0, j = bh * 33 + c;
                gla_passC_item(lds, (const GAS bf16*)proj_p, (GAS bf16*)ymix_p, gg, bh & 3, bh >> 2, c, wave,
                               (const GAS bf16*)(ws_p + WS_GQS) + (size_t)j * 8192, (const GAS bf16*)(ws_p + WS_GPL) + (size_t)j * 4096, (const GAS bf16*)(ws_p + WS_GS) + (size_t)j * 32768); }
            SEAM(pb + 6);
        }
        if (IN(pb + 7)) { PH_LOCALS();
            pg8::Gemm g{ymix_p, (const bf16*)(wl + WO_OUT), TP, D, D}; pg8::TailSplitOrder<TSP> S; S.init(TP, D, D, G_, bx_);
            pg8::EpiResid E{hbuf_p, D, 1.0f, (float*)(ws_p + WS_SLAB)};
            pg8::gemm_phase<pg8::EpiResid, pg8::TailSplitOrder<TSP>, true, true>(lds, g, S, E, wave);
            CONVERT_IN_TAIL(S.ntail() * TSP, CV3, CV4);
            SEAM(pb + 7);
        }
        if (IN(pb + 8)) { PH_LOCALS(); norm_phase<0>(nullptr, nullptr, nullptr, hbuf_p, args.in[16] + (size_t)l_p * D, xn_p, nullptr, gw_p, ngw_p, lane_p, (const float*)(ws_p + WS_SLAB), 1.0f, D, G_, lds, tid_p); SEAM(pb + 8); }
        if (IN(pb + 9)) { PH_LOCALS();
            pg8::Gemm g{hbuf_p, (const bf16*)(wl + WO_GU2), TP, NGU, D}; pg8::StaticOrder S; S.init(TP, NGU, D, G_, bx_);
            pg8::EpiSwiGLU E{act_p, FF, xn_p};
            pg8::gemm_phase<pg8::EpiSwiGLU, pg8::StaticOrder, true, true>(lds, g, S, E, wave);
            CONVERT_IN_TAIL(S.nwg % G_, CV4, CV5);
            SEAM(pb + 9);
        }
        if (IN(pb + 10)) { PH_LOCALS();
            pg8::Gemm g{act_p, (const bf16*)(wl + WO_DN2), TP, D, FF}; pg8::TailSplitOrder<TSP> S; S.init(TP, D, FF, G_, bx_);
            pg8::EpiResid E{hbuf_p, D, 0.5f, (float*)(ws_p + WS_SLAB)};
            pg8::gemm_phase<pg8::EpiResid, pg8::TailSplitOrder<TSP>, true, true>(lds, g, S, E, wave);
            CONVERT_IN_TAIL(S.ntail() * TSP, CV5, CV6);
            SEAM(pb + 10);
        }
        if (IN(pb + 11)) { PH_LOCALS();
            if (l_p + 1 < DEPTH) norm_phase<0>(nullptr, nullptr, nullptr, hbuf_p, args.in[5] + (size_t)(l_p + 1) * D, xn_p, nullptr, gw_p, ngw_p, lane_p, (const float*)(ws_p + WS_SLAB), 0.5f, FF, G_, lds, tid_p);
            else norm_phase<2>(nullptr, nullptr, nullptr, hbuf_p, args.in[19], nullptr, args.out, gw_p, ngw_p, lane_p, (const float*)(ws_p + WS_SLAB), 0.5f, FF, G_, lds, tid_p);
            SEAM(pb + 11);
        }
    }
#undef PH_LOCALS
#undef CONVERT_RANGE
#undef CONVERT_IN_TAIL
#undef IN
#undef SEAM
}

extern "C" void kernel_launch(void* const* d_in, const int* in_sizes, int n_in, void* d_out, int out_size, void* d_ws, size_t ws_size, hipStream_t stream) {
    static int grid = 0;
    if (grid == 0) {
        if (n_in != 20 || (size_t)out_size != O_END || ws_size < WS_END) { fprintf(stderr, "kernel_launch: unexpected shapes (n_in %d, out %d, ws %zu); nothing launched\n", n_in, out_size, ws_size); grid = -1; return; }
        int dev = 0, cus = 0, per_cu = 0;
        if (hipGetDevice(&dev) != hipSuccess || hipDeviceGetAttribute(&cus, hipDeviceAttributeMultiprocessorCount, dev) != hipSuccess) { grid = -1; return; }
        if (hipFuncSetAttribute((const void*)mk_fwd, hipFuncAttributeMaxDynamicSharedMemorySize, LDS_BYTES) != hipSuccess) { fprintf(stderr, "kernel_launch: hipFuncSetAttribute failed\n"); grid = -1; return; }
        if (hipOccupancyMaxActiveBlocksPerMultiprocessor(&per_cu, (const void*)mk_fwd, NWAVES * 64, LDS_BYTES) != hipSuccess || per_cu < 1)
            fprintf(stderr, "kernel_launch: occupancy query reports %d workgroups per CU\n", per_cu);
        (void)hipGetLastError();
        grid = cus;
        if (grid < 32) grid = 32;
    }
    if (grid < 0) return;
    (void)hipMemsetAsync((char*)d_ws + WS_CTL, 0, CTL_ZERO_BYTES, stream);
    Args a{};
    for (int i = 0; i < 20; ++i) a.in[i] = (const float*)d_in[i];
    a.out = (float*)d_out; a.ws = (unsigned char*)d_ws;
    if (MK_N_LAUNCHES == 1) {
        a.ph_lo = 0; a.ph_hi = N_PHASES;
        hipLaunchKernelGGL(mk_fwd, dim3(grid), dim3(NWAVES * 64), LDS_BYTES, stream, a);
    } else {
        for (int p = 0; p < N_PHASES; ++p) { a.ph_lo = p; a.ph_hi = p + 1; hipLaunchKernelGGL(mk_fwd, dim3(grid), dim3(NWAVES * 64), LDS_BYTES, stream, a); }
    }
}
```

```cpp
#include <hip/hip_runtime.h>
#include <cstdio>
#include <cstdint>

#ifndef MK_N_LAUNCHES
#define MK_N_LAUNCHES 1
#endif

__device__ __forceinline__ int fresh_lane() { unsigned z = 0u; asm volatile("" : "+s"(z)); return (int)__builtin_amdgcn_mbcnt_hi(~0u, __builtin_amdgcn_mbcnt_lo(~0u, z)); }
namespace pg8 {
#define PG8_LAS __attribute__((address_space(3)))
#define PG8_GAS __attribute__((address_space(1)))
typedef unsigned short bf16_t;
typedef short bf16x8 __attribute__((ext_vector_type(8)));
typedef float f32x4 __attribute__((ext_vector_type(4)));
typedef unsigned u32x4 __attribute__((ext_vector_type(4)));
constexpr int BM = 256, BK = 64, HALF = 128, HTB = HALF * BK * 2  , STAGE_BYTES = 8 * HTB, NXCD = 8, WGM = 8;

__host__ __device__ __forceinline__ int lds_byte(int r, int c) { const int st = (r >> 4) * 2 + (c >> 5), rr = r & 15, cc = c & 31, ob = rr * 64 + cc * 2; return st * 1024 + (ob ^ (((ob >> 9) & 1) << 5)); }
__host__ __device__ __forceinline__ void stage_rc(int b, int& R, int& C) { const int st = b / 1024, sb = b % 1024, swz = sb ^ (((sb >> 9) & 1) << 5); R = (st >> 1) * 16 + swz / 64; C = (st & 1) * 32 + (swz % 64) / 2; }
__host__ __device__ __forceinline__ int perm32(int rho) { const int n = rho >> 4, i = rho & 15; return 8 * (i >> 2) + 4 * n + (i & 3); }

struct Unit { int pm, pn, kt0, nkt, slab; };
struct Gemm { const bf16_t* A; const bf16_t* Bt; int M, N, K; };

struct StaticOrder {
    int nM, nN, nwg, G, c, nkt;
    __host__ __device__ void init(int M, int N, int K, int G_, int c_) { nM = M / BM; nN = N / BM; nwg = nM * nN; G = G_; c = c_; nkt = K / BK; }
    __host__ __device__ bool next(int i, Unit& u) const {
        const long L = (long)i * G + c; if (L >= nwg) return false;
        u.kt0 = 0; u.nkt = nkt; u.slab = -1;
        int wgid = (int)L; { const int q = nwg / NXCD, r = nwg % NXCD, xcd = wgid % NXCD, off = wgid / NXCD; wgid = (xcd < r ? xcd * (q + 1) : r * (q + 1) + (xcd - r) * q) + off; }
        const int nig = WGM * nN, gid = wgid / nig, fm = gid * WGM, gsz = (nM - fm) < WGM ? (nM - fm) : WGM;
        u.pm = fm + ((wgid % nig) % gsz); u.pn = (wgid % nig) / gsz; return true;
    }
    __device__ __forceinline__ void a_ready(const Unit&) const {}
    __device__ __forceinline__ void done(const Unit&) const {}
};

template <int SP> struct TailSplitOrder : StaticOrder {
    __host__ __device__ int ntail() const { return nwg % G; }
    __host__ __device__ int rounds() const { return nwg / G; }
    __host__ __device__ bool tail_unit(int tu, Unit& u) const { StaticOrder t = *this; t.c = tu; return t.next(rounds(), u); }
    __host__ __device__ bool next(int i, Unit& u) const {
        const int R = rounds(), nt = ntail();
        if (i < R) return StaticOrder::next(i, u);
        if (i > R || nt == 0) return false;
        if (nt * SP > G || (nkt % (2 * SP)) != 0) return StaticOrder::next(i, u);
        if (c >= nt * SP) return false;
        const int tu = c % nt, ks = c / nt;
        if (!tail_unit(tu, u)) return false;
        u.nkt = nkt / SP; u.kt0 = ks * u.nkt; u.slab = tu * SP + ks; return true;
    }
};

typedef __bf16 bf16x2v __attribute__((ext_vector_type(2)));
typedef float f32x2v __attribute__((ext_vector_type(2)));
__device__ __forceinline__ unsigned cvt_pk_bf16(float lo, float hi) { const f32x2v v = {lo, hi}; const bf16x2v r = __builtin_convertvector(v, bf16x2v); return __builtin_bit_cast(unsigned, r); }

struct EpiBf16 {
    static constexpr bool PERM = true, AFTER_DRAIN = false;
    bf16_t* O; int ldc; const float* rs;
    __device__ __forceinline__ void operator()(const f32x4 (&acc)[2][2][4][2], const Unit& u, int wr, int wc, int fr, int fq) const {
        const int row0 = u.pm * BM + wr * 64 + fr; const int col0 = u.pn * BM + wc * 32 + 8 * fq;
        float rr[2][4];
#pragma unroll
        for (int ai = 0; ai < 2; ++ai)
#pragma unroll
            for (int m = 0; m < 4; ++m) rr[ai][m] = ((const PG8_GAS float*)rs)[row0 + ai * HALF + m * 16];
#pragma unroll
        for (int ai = 0; ai < 2; ++ai)
#pragma unroll
            for (int m = 0; m < 4; ++m) { PG8_GAS bf16_t* rowp = (PG8_GAS bf16_t*)O + (size_t)(row0 + ai * HALF + m * 16) * ldc + col0; const float r = rr[ai][m];
#pragma unroll
                for (int bj = 0; bj < 2; ++bj) { const f32x4 v0 = acc[ai][bj][m][0] * r, v1 = acc[ai][bj][m][1] * r;
                    u32x4 w; w.x = cvt_pk_bf16(v0[0], v0[1]); w.y = cvt_pk_bf16(v0[2], v0[3]); w.z = cvt_pk_bf16(v1[0], v1[1]); w.w = cvt_pk_bf16(v1[2], v1[3]);
                    *(PG8_GAS u32x4*)(rowp + bj * HALF) = w; } }
    }
};
struct EpiSwiGLU {
    static constexpr bool PERM = true, AFTER_DRAIN = false;
    bf16_t* O; int ldc; const float* rs;
    __device__ __forceinline__ static float silu_mul(float a, float b) { return a * __builtin_amdgcn_rcpf(1.0f + __builtin_amdgcn_exp2f(-1.44269504089f * a)) * b; }
    __device__ __forceinline__ void operator()(const f32x4 (&acc)[2][2][4][2], const Unit& u, int wr, int wc, int fr, int fq) const {
        const int row0 = u.pm * BM + wr * 64 + fr; const int col0 = u.pn * HALF + wc * 32 + 8 * fq;
        float rr[2][4];
#pragma unroll
        for (int ai = 0; ai < 2; ++ai)
#pragma unroll
            for (int m = 0; m < 4; ++m) rr[ai][m] = ((const PG8_GAS float*)rs)[row0 + ai * HALF + m * 16];
#pragma unroll
        for (int ai = 0; ai < 2; ++ai)
#pragma unroll
            for (int m = 0; m < 4; ++m) { PG8_GAS bf16_t* rowp = (PG8_GAS bf16_t*)O + (size_t)(row0 + ai * HALF + m * 16) * ldc + col0;
                const float r = rr[ai][m];
                const f32x4 a0 = acc[ai][0][m][0] * r, a1 = acc[ai][0][m][1] * r, b0 = acc[ai][1][m][0] * r, b1 = acc[ai][1][m][1] * r;
                f32x4 e0, e1;
#pragma unroll
                for (int j = 0; j < 4; ++j) { e0[j] = __builtin_amdgcn_exp2f(-1.44269504089f * a0[j]); e1[j] = __builtin_amdgcn_exp2f(-1.44269504089f * a1[j]); }
                f32x4 r0, r1;
#pragma unroll
                for (int j = 0; j < 4; ++j) { r0[j] = __builtin_amdgcn_rcpf(1.0f + e0[j]); r1[j] = __builtin_amdgcn_rcpf(1.0f + e1[j]); }
                const f32x4 s0 = a0 * r0 * b0, s1 = a1 * r1 * b1;
                u32x4 w; w.x = cvt_pk_bf16(s0[0], s0[1]); w.y = cvt_pk_bf16(s0[2], s0[3]); w.z = cvt_pk_bf16(s1[0], s1[1]); w.w = cvt_pk_bf16(s1[2], s1[3]);
                *(PG8_GAS u32x4*)rowp = w; }
    }
};
struct EpiResid {
    static constexpr bool PERM = false, AFTER_DRAIN = false;
    bf16_t* C; int ldc; float scale; float* slabs;
    __device__ __forceinline__ void operator()(const f32x4 (&acc)[2][2][4][2], const Unit& u, int wr, int wc, int fr, int fq) const {
        if (u.slab >= 0) {
            typedef unsigned u32x2 __attribute__((ext_vector_type(2)));
            PG8_GAS bf16_t* sp = (PG8_GAS bf16_t*)slabs + (size_t)u.slab * (BM * BM) + (size_t)(wr * 64 + fr) * BM + wc * 32 + 4 * fq;
#pragma unroll
            for (int ai = 0; ai < 2; ++ai)
#pragma unroll
                for (int m = 0; m < 4; ++m)
#pragma unroll
                    for (int bj = 0; bj < 2; ++bj)
#pragma unroll
                        for (int n = 0; n < 2; ++n) { const f32x4 v = acc[ai][bj][m][n]; *(PG8_GAS u32x2*)(sp + (size_t)(ai * HALF + m * 16) * BM + bj * HALF + n * 16) = (u32x2){cvt_pk_bf16(v[0], v[1]), cvt_pk_bf16(v[2], v[3])}; }
            return;
        }
        const int row0 = u.pm * BM + wr * 64 + fr, col0 = u.pn * BM + wc * 32 + 4 * fq;
        typedef unsigned u32x2 __attribute__((ext_vector_type(2)));
        u32x2 old[2][4][2][2];
#pragma unroll
        for (int ai = 0; ai < 2; ++ai)
#pragma unroll
            for (int m = 0; m < 4; ++m) { const PG8_GAS bf16_t* rowp = (const PG8_GAS bf16_t*)C + (size_t)(row0 + ai * HALF + m * 16) * ldc + col0;
#pragma unroll
                for (int bj = 0; bj < 2; ++bj)
#pragma unroll
                    for (int n = 0; n < 2; ++n) old[ai][m][bj][n] = *(const PG8_GAS u32x2*)(rowp + bj * HALF + n * 16); }
#pragma unroll
        for (int ai = 0; ai < 2; ++ai)
#pragma unroll
            for (int m = 0; m < 4; ++m) { PG8_GAS bf16_t* rowp = (PG8_GAS bf16_t*)C + (size_t)(row0 + ai * HALF + m * 16) * ldc + col0;
#pragma unroll
                for (int bj = 0; bj < 2; ++bj)
#pragma unroll
                    for (int n = 0; n < 2; ++n) { const u32x2 o = old[ai][m][bj][n]; const f32x4 a = acc[ai][bj][m][n];
                        const float y0 = __builtin_bit_cast(float, o.x << 16) + a[0] * scale, y1 = __builtin_bit_cast(float, o.x & 0xffff0000u) + a[1] * scale;
                        const float y2 = __builtin_bit_cast(float, o.y << 16) + a[2] * scale, y3 = __builtin_bit_cast(float, o.y & 0xffff0000u) + a[3] * scale;
                        *(PG8_GAS u32x2*)(rowp + bj * HALF + n * 16) = (u32x2){cvt_pk_bf16(y0, y1), cvt_pk_bf16(y2, y3)}; } }
    }
};

template <class Epi, class Sched, bool ALIGN_EPI = false, bool SP2 = false>
__device__ __forceinline__ void gemm_phase(PG8_LAS unsigned char* lds, const Gemm g, const Sched& S, const Epi& E, const int wave_id) {
    int tid_ = wave_id * 64 + fresh_lane(); asm volatile("" : "+v"(tid_));
    const int tid = tid_, wid = __builtin_amdgcn_readfirstlane(tid >> 6), lane = tid & 63, wr = wid >> 2, wc = wid & 3, fr = lane & 15, fq = lane >> 4;
    const int K = g.K;
    unsigned voffA[2], voffB[2];
#pragma unroll
    for (int i = 0; i < 2; ++i) { int R, C; stage_rc(tid * 16 + i * 8192, R, C); const int Rb = Epi::PERM ? ((R & ~31) + perm32(R & 31)) : R;
        voffA[i] = (unsigned)(R * K + C) * 2u; voffB[i] = (unsigned)(Rb * K + C) * 2u; }
    const size_t kstep = (size_t)(BK * 2);
    const size_t hstep = (size_t)HALF * K * 2;
    const size_t tstep = 2 * hstep;
    const unsigned ldsw = (unsigned)wid * 1024u;
    const int aoff = lds_byte(wr * 64 + fr, fq * 8), boff = lds_byte(wc * 32 + fr, fq * 8);
#define PG8_SA(b, h) (((b) * 2 + (h)) * HTB)
#define PG8_SB(b, h) ((4 + (b) * 2 + (h)) * HTB)
#define PG8_STAGE(bufoff, gbase, voff) do { _Pragma("unroll") for (int _i = 0; _i < 2; ++_i) \
        __builtin_amdgcn_global_load_lds((const unsigned*)((const char*)(gbase) + (voff)[_i]), (PG8_LAS unsigned*)(lds + (bufoff) + ldsw + _i * 8192), 16, 0, 0); } while (0)
#define PG8_LDA(dst, b, h) do { _Pragma("unroll") for (int m = 0; m < 4; ++m) _Pragma("unroll") for (int k = 0; k < 2; ++k) dst[m][k] = *(const PG8_LAS bf16x8*)(lds + PG8_SA(b, h) + aoff + m * 2048 + k * 1024); } while (0)
#define PG8_LDB(dst, b, h) do { _Pragma("unroll") for (int n = 0; n < 2; ++n) _Pragma("unroll") for (int k = 0; k < 2; ++k) dst[n][k] = *(const PG8_LAS bf16x8*)(lds + PG8_SB(b, h) + boff + n * 2048 + k * 1024); } while (0)
#define PG8_MMA(ai, bj, At, Bt) do { __builtin_amdgcn_s_setprio(1); _Pragma("unroll") for (int m = 0; m < 4; ++m) _Pragma("unroll") for (int n = 0; n < 2; ++n) _Pragma("unroll") for (int k = 0; k < 2; ++k) \
        acc[ai][bj][m][n] = __builtin_amdgcn_mfma_f32_16x16x32_bf16(Bt[n][k], At[m][k], acc[ai][bj][m][n], 0, 0, 0); __builtin_amdgcn_s_setprio(0); } while (0)
#define PG8_WAIT_V(n) asm volatile("s_waitcnt vmcnt(" #n ")" ::: "memory")
#define PG8_WAIT_L(n) asm volatile("s_waitcnt lgkmcnt(" #n ")" ::: "memory")
#define PG8_BAR __builtin_amdgcn_s_barrier()
#define PG8_SCHED __builtin_amdgcn_sched_barrier(0)
    Unit cur, nxt; int ui = 0;
    if (!S.next(0, cur)) return;
    f32x4 acc[2][2][4][2];
#pragma unroll
    for (int a = 0; a < 2; ++a)
#pragma unroll
        for (int b = 0; b < 2; ++b)
#pragma unroll
            for (int m = 0; m < 4; ++m)
#pragma unroll
                for (int n = 0; n < 2; ++n) acc[a][b][m][n] = (f32x4){0.f, 0.f, 0.f, 0.f};
    bf16x8 At[4][2], B0[2][2], B1[2][2];
    const char* cA = (const char*)g.A + (size_t)cur.pm * tstep + (size_t)cur.kt0 * kstep; const char* cB = (const char*)g.Bt + (size_t)cur.pn * tstep + (size_t)cur.kt0 * kstep;
    S.a_ready(cur);
    if constexpr (SP2) {
        PG8_STAGE(PG8_SB(0, 0), cB, voffB); PG8_STAGE(PG8_SB(0, 1), cB + hstep, voffB); PG8_STAGE(PG8_SA(0, 0), cA, voffA); PG8_STAGE(PG8_SA(0, 1), cA + hstep, voffA);
        if (wr == 1) PG8_BAR;
        PG8_WAIT_V(2); PG8_BAR;
        PG8_STAGE(PG8_SB(1, 0), cB + kstep, voffB); PG8_STAGE(PG8_SA(1, 0), cA + kstep, voffA); PG8_STAGE(PG8_SB(1, 1), cB + hstep + kstep, voffB);
        PG8_WAIT_V(6); PG8_BAR;
    } else {
        PG8_STAGE(PG8_SB(0, 0), cB, voffB); PG8_STAGE(PG8_SA(0, 0), cA, voffA); PG8_STAGE(PG8_SB(0, 1), cB + hstep, voffB); PG8_STAGE(PG8_SA(0, 1), cA + hstep, voffA);
        if (wr == 1) PG8_BAR;
        PG8_WAIT_V(4); PG8_BAR;
        PG8_STAGE(PG8_SB(1, 0), cB + kstep, voffB); PG8_STAGE(PG8_SA(1, 0), cA + kstep, voffA); PG8_STAGE(PG8_SB(1, 1), cB + hstep + kstep, voffB);
        PG8_WAIT_V(6); PG8_BAR;
    }
    for (;;) {
        const bool has_next = S.next(ui + 1, nxt);
        const char* nA = has_next ? (const char*)g.A + (size_t)nxt.pm * tstep + (size_t)nxt.kt0 * kstep : cA; const char* nB = has_next ? (const char*)g.Bt + (size_t)nxt.pn * tstep + (size_t)nxt.kt0 * kstep : cB;
        const int nt = cur.nkt;
        for (int t = 0; t < nt; t += 2) {
            const bool last = (t == nt - 2);
            const char* a1 = cA + (size_t)(t + 1) * kstep;
            const char* a2 = last ? nA : cA + (size_t)(t + 2) * kstep; const char* b2 = last ? nB : cB + (size_t)(t + 2) * kstep;
            const char* a3 = a2 + kstep; const char* b3 = b2 + kstep;
            if (last && has_next) S.a_ready(nxt);
            if constexpr (SP2) {
            PG8_LDB(B0, 0, 0); PG8_LDB(B1, 0, 1); PG8_SCHED; PG8_LDA(At, 0, 0); PG8_STAGE(PG8_SA(1, 1), a1 + hstep, voffA);
            PG8_WAIT_V(8); PG8_WAIT_L(0); PG8_BAR; PG8_MMA(0, 0, At, B0); PG8_MMA(0, 1, At, B1); PG8_BAR; PG8_SCHED;
            PG8_LDA(At, 0, 1); PG8_STAGE(PG8_SB(0, 0), b2, voffB); PG8_STAGE(PG8_SB(0, 1), b2 + hstep, voffB); PG8_STAGE(PG8_SA(0, 0), a2, voffA);
            PG8_WAIT_V(8); PG8_WAIT_L(0); PG8_BAR; PG8_MMA(1, 0, At, B0); PG8_MMA(1, 1, At, B1); PG8_BAR; PG8_SCHED;
            PG8_LDB(B0, 1, 0); PG8_LDB(B1, 1, 1); PG8_SCHED; PG8_LDA(At, 1, 0); PG8_STAGE(PG8_SA(0, 1), a2 + hstep, voffA);
            PG8_WAIT_V(8); PG8_WAIT_L(0); PG8_BAR; PG8_MMA(0, 0, At, B0); PG8_MMA(0, 1, At, B1); PG8_BAR; PG8_SCHED;
            PG8_LDA(At, 1, 1); PG8_STAGE(PG8_SB(1, 0), b3, voffB); PG8_STAGE(PG8_SB(1, 1), b3 + hstep, voffB); PG8_STAGE(PG8_SA(1, 0), a3, voffA);
            PG8_WAIT_V(8); PG8_WAIT_L(0); PG8_BAR; PG8_MMA(1, 0, At, B0); PG8_MMA(1, 1, At, B1); PG8_BAR; PG8_SCHED;
            } else {
            PG8_LDB(B0, 0, 0); PG8_SCHED; PG8_LDA(At, 0, 0); PG8_STAGE(PG8_SA(1, 1), a1 + hstep, voffA);
            PG8_WAIT_L(8); PG8_BAR; PG8_WAIT_L(0); PG8_MMA(0, 0, At, B0); PG8_BAR; PG8_SCHED;
            PG8_LDB(B1, 0, 1); PG8_STAGE(PG8_SB(0, 0), b2, voffB);
            PG8_BAR; PG8_WAIT_L(0); PG8_MMA(0, 1, At, B1); PG8_BAR;
            PG8_LDA(At, 0, 1); PG8_STAGE(PG8_SA(0, 0), a2, voffA);
            PG8_BAR; PG8_WAIT_L(0); PG8_MMA(1, 0, At, B0); PG8_BAR; PG8_SCHED;
            PG8_STAGE(PG8_SB(0, 1), b2 + hstep, voffB);
            PG8_WAIT_V(6); PG8_BAR; PG8_MMA(1, 1, At, B1); PG8_BAR;
            PG8_LDB(B0, 1, 0); PG8_SCHED; PG8_LDA(At, 1, 0); PG8_STAGE(PG8_SA(0, 1), a2 + hstep, voffA);
            PG8_WAIT_L(8); PG8_BAR; PG8_WAIT_L(0); PG8_MMA(0, 0, At, B0); PG8_BAR; PG8_SCHED;
            PG8_LDB(B1, 1, 1); PG8_STAGE(PG8_SB(1, 0), b3, voffB);
            PG8_BAR; PG8_WAIT_L(0); PG8_MMA(0, 1, At, B1); PG8_BAR;
            PG8_LDA(At, 1, 1); PG8_STAGE(PG8_SA(1, 0), a3, voffA);
            PG8_BAR; PG8_WAIT_L(0); PG8_MMA(1, 0, At, B0); PG8_BAR; PG8_SCHED;
            PG8_STAGE(PG8_SB(1, 1), b3 + hstep, voffB);
            PG8_WAIT_V(6); PG8_BAR; PG8_MMA(1, 1, At, B1); PG8_BAR;
            }
        }
        if constexpr (ALIGN_EPI) { if (wr == 0) PG8_BAR; }
        if constexpr (!Epi::AFTER_DRAIN) { E(acc, cur, wr, wc, fr, fq); S.done(cur); }
        if (!has_next) break;
#pragma unroll
        for (int a = 0; a < 2; ++a)
#pragma unroll
            for (int b = 0; b < 2; ++b)
#pragma unroll
                for (int m = 0; m < 4; ++m)
#pragma unroll
                    for (int n = 0; n < 2; ++n) acc[a][b][m][n] = (f32x4){0.f, 0.f, 0.f, 0.f};
        cur = nxt; cA = nA; cB = nB; ++ui;
        if constexpr (ALIGN_EPI) { if (wr == 1) PG8_BAR; }
    }
    PG8_WAIT_V(0);
    if constexpr (!ALIGN_EPI) { if (wr == 0) PG8_BAR; }
    PG8_BAR;
#undef PG8_SA
#undef PG8_SB
#undef PG8_STAGE
#undef PG8_LDA
#undef PG8_LDB
#undef PG8_MMA
#undef PG8_WAIT_V
#undef PG8_WAIT_L
#undef PG8_BAR
#undef PG8_SCHED
}
}

constexpr int NWAVES = 8;
constexpr int D = 2048, FF = 5632, NGU = 2 * FF, DEPTH = 4;
constexpr int DCONV = 1024, GH = 4, GDK = 128, GDV = 256, GRANK = 16;
constexpr int NIN = 6160, NINP = 6400;
constexpr int R_SAMPLE = 8192, R_META = 9216, T_REAL = 9280, TP = 9472;
constexpr int PC_B = 0, PC_C = 1024, PC_H = 2048, PC_Q = 3072, PC_K = 3584, PC_V = 4096, PC_GO = 5120, PC_FL = 6144;
constexpr float EPS = 1e-6f;
constexpr size_t O_YP = 0, O_YS = 16777216, O_GP = 18874368, O_CP = 20971520, O_GS = 21004288, O_CS = 88113152, O_END = 89161728;
constexpr size_t MiB = 1u << 20;
constexpr size_t WS_CTL = 0, CTL_ZERO_BYTES = 32768;
constexpr size_t WS_W = 2 * MiB, W_LAYER = 165 * MiB;
constexpr size_t WO_GU1 = 0, WO_DN1 = 44 * MiB, WO_IN = 66 * MiB, WO_OUT = 91 * MiB, WO_GU2 = 99 * MiB, WO_DN2 = 143 * MiB;
constexpr size_t WS_H = 664 * MiB, WS_XN = 738 * MiB, WS_ACT = 776 * MiB, WS_PROJ = 878 * MiB, WS_YMIX = 994 * MiB, WS_SLAB = 1032 * MiB, WS_GQS = 1096 * MiB, WS_GPL = 1105 * MiB, WS_GEBL = 1110 * MiB, WS_GU = 1111 * MiB, WS_GS = 1177 * MiB, WS_END = 1210 * MiB;
static_assert(WS_W + DEPTH * W_LAYER <= WS_H && WS_H + (size_t)TP * D * 4 <= WS_XN && WS_XN + (size_t)TP * D * 2 <= WS_ACT && WS_ACT + (size_t)TP * FF * 2 <= WS_PROJ &&
              WS_PROJ + (size_t)TP * NINP * 2 <= WS_YMIX && WS_YMIX + (size_t)TP * D * 2 <= WS_SLAB && WS_SLAB + (size_t)256 * 65536 * 4 <= WS_GQS && WS_GQS + (size_t)528 * 16384 <= WS_GPL && WS_GPL + (size_t)528 * 8192 <= WS_GEBL && WS_GEBL + (size_t)528 * 512 <= WS_GU && WS_GU + (size_t)528 * 131072 <= WS_GS && WS_GS + (size_t)528 * 65536 <= WS_END, "d_ws map");
constexpr int TSP = 4;
constexpr int CW_BAR = 4096;
static_assert((CW_BAR + 3456) * 4 <= (int)CTL_ZERO_BYTES, "the per-call memset covers the barrier words");
constexpr int LDS_BYTES = 147456, MISC_OFF = 143360;

#define GAS __attribute__((address_space(1)))
#define LAS __attribute__((address_space(3)))
typedef unsigned short bf16;
typedef unsigned v4u __attribute__((ext_vector_type(4)));
typedef unsigned v2u __attribute__((ext_vector_type(2)));
typedef float f32x4 __attribute__((ext_vector_type(4)));
typedef float f32x2 __attribute__((ext_vector_type(2)));
#define DI __device__ __forceinline__
#define LDS_WAIT() asm volatile("s_waitcnt lgkmcnt(0)" ::: "memory")
DI unsigned f2bf(float f) { unsigned u = __builtin_bit_cast(unsigned, f); return (u + 0x7fffu + ((u >> 16) & 1u)) >> 16; }
typedef __bf16 bf16x2_t __attribute__((ext_vector_type(2)));
DI unsigned pk2(float lo, float hi) { f32x2 v = {lo, hi}; bf16x2_t r = __builtin_convertvector(v, bf16x2_t); return __builtin_bit_cast(unsigned, r); }
DI float bflo(unsigned w) { return __uint_as_float(w << 16); }
DI float bfhi(unsigned w) { return __uint_as_float(w & 0xffff0000u); }

#define XB_TMO      128
#define XB_XCNT(j)  (256  + 64 * (j))
#define XB_XSUB(j)  (1280 + 64 * (j))
#define XB_XGEN(j)  (2304 + 64 * (j))
#define XB_TOP      3328
#define XB_TOPGEN   3392
#define XCD_BAR_WORDS 3456
#define XB_SPIN_CAP (1u << 22)
__device__ __forceinline__ unsigned xb_ld(unsigned* p)              { return __hip_atomic_load(p, __ATOMIC_RELAXED, __HIP_MEMORY_SCOPE_AGENT); }
__device__ __forceinline__ unsigned xb_add(unsigned* p, unsigned v) { return __hip_atomic_fetch_add(p, v, __ATOMIC_RELAXED, __HIP_MEMORY_SCOPE_AGENT); }
__device__ __forceinline__ unsigned xb_xcc_id() { return (unsigned)__builtin_amdgcn_s_getreg((3 << 11) | 20) & 0xFu; }
#define XB_SPIN(cond, bar) do { unsigned _sp = 0; while (cond) { __builtin_amdgcn_s_sleep(1); \
    if ((++_sp & 255u) == 0u) { if (xb_ld(&(bar)[XB_TMO])) break; if (_sp > XB_SPIN_CAP) { atomicAdd(&(bar)[XB_TMO], 1u); break; } } } } while (0)
struct XcdBarrier { unsigned* bar; unsigned x; volatile LAS unsigned* st; };
__device__ __forceinline__ bool xb_t0(int wave_id) { return wave_id == 0 && fresh_lane() == 0; }
__device__ __forceinline__ XcdBarrier xcd_barrier_post(unsigned* bar, volatile LAS unsigned* st, int wave_id) {
    XcdBarrier b; b.bar = bar; b.x = xb_xcc_id(); b.st = st;
    if (xb_t0(wave_id)) (void)xb_add(&bar[XB_XCNT(b.x)], 1u);
    return b;
}
__device__ __forceinline__ void xcd_barrier_complete(unsigned* bar, unsigned x, unsigned& nloc, unsigned& nx) {
    const unsigned G = gridDim.x * gridDim.y * gridDim.z;
    unsigned sum, cnt, mine, sp = 0u;
    for (;;) {
        sum = 0u; cnt = 0u; mine = 0u;
#pragma unroll
        for (unsigned j = 0; j < 16; ++j) { const unsigned c = xb_ld(&bar[XB_XCNT(j)]); sum += c; cnt += (c > 0u) ? 1u : 0u; mine = (j == x) ? c : mine; }
        if (sum == G) break;
        __builtin_amdgcn_s_sleep(1);
        if ((++sp & 255u) == 0u) { if (xb_ld(&bar[XB_TMO])) break; if (sp > XB_SPIN_CAP) { atomicAdd(&bar[XB_TMO], 1u); break; } }
    }
    nloc = mine > 0u ? mine : 1u; nx = cnt > 0u ? cnt : 1u;
}
__device__ __forceinline__ void xcd_barrier(const XcdBarrier& b, int wave_id) {
    asm volatile("s_waitcnt vmcnt(0)" ::: "memory");
    __syncthreads();
    if (xb_t0(wave_id)) {
        unsigned* bar = b.bar;
        __builtin_amdgcn_s_waitcnt(0);
        unsigned nloc = b.st[0], nx = b.st[1];
        if (nloc == 0u) { xcd_barrier_complete(bar, b.x, nloc, nx); b.st[0] = nloc; b.st[1] = nx; }
        const unsigned old = xb_add(&bar[XB_XSUB(b.x)], 1u);
        const unsigned gen = old / nloc;
        if (old + 1u == (gen + 1u) * nloc) {
            __builtin_amdgcn_fence(__ATOMIC_RELEASE, "agent");
            asm volatile("s_waitcnt vmcnt(0)" ::: "memory");
            const unsigned og = xb_add(&bar[XB_TOP], 1u);
            const unsigned tg = og / nx;
            if (og + 1u == (tg + 1u) * nx) xb_add(&bar[XB_TOPGEN], 1u);
            else XB_SPIN(xb_ld(&bar[XB_TOPGEN]) == tg, bar);
            __builtin_amdgcn_fence(__ATOMIC_ACQUIRE, "agent");
            xb_add(&bar[XB_XGEN(b.x)], 1u);
            asm volatile("s_waitcnt vmcnt(0)" ::: "memory");
        } else {
            XB_SPIN(xb_ld(&bar[XB_XGEN(b.x)]) == gen, bar);
            __builtin_amdgcn_fence(__ATOMIC_ACQUIRE, "agent");
            asm volatile("s_waitcnt vmcnt(0)" ::: "memory");
        }
    }
    __syncthreads();
}

DI float wave_sum(float v) {
#pragma unroll
    for (int o = 1; o < 64; o <<= 1) v += __shfl_xor(v, o);
    return v;
}
DI int row_prompt(int b, int pos) { return pos < 16 ? R_META + b * 16 + pos : b * 2048 + pos - 16; }

DI int dst_row(int kind, int n) { if (kind == 0) return n; const int a = n < FF ? n : n - FF; return 256 * (a >> 7) + (n < FF ? 0 : 128) + (a & 127); }
struct CvItem { const float* W; bf16* WT; int K, N, kind, kb, nb; const float* G; };
DI void cv_load(const CvItem& it, int lane, f32x4 (&v)[16], f32x4 (&g)[2]) {
    const int k0 = 64 * it.kb, n0 = 64 * it.nb, lr = lane >> 4, lc = 4 * (lane & 15);
    const bool inb = (n0 + lc) < it.N;
#pragma unroll
    for (int i = 0; i < 16; ++i) v[i] = inb ? __builtin_nontemporal_load((const f32x4*)(it.W + (size_t)(k0 + 4 * i + lr) * it.N + n0 + lc)) : (f32x4){0.f, 0.f, 0.f, 0.f};
    if (it.G) { g[0] = *(const f32x4*)(it.G + k0 + 8 * (lane & 7)); g[1] = *(const f32x4*)(it.G + k0 + 8 * (lane & 7) + 4); } else { g[0] = (f32x4){1.f, 1.f, 1.f, 1.f}; g[1] = g[0]; }
}
DI void cv_finish(const CvItem& it, const f32x4 (&v)[16], const f32x4 (&g)[2], LAS float* scr, int lane) {
    const int k0 = 64 * it.kb, n0 = 64 * it.nb, lr = lane >> 4, lc = 4 * (lane & 15);
#pragma unroll
    for (int i = 0; i < 16; ++i) { LAS float* s = scr + (4 * i + lr) * 65 + lc; s[0] = v[i][0]; s[1] = v[i][1]; s[2] = v[i][2]; s[3] = v[i][3]; }
    LDS_WAIT(); asm volatile("" ::: "memory");
    const int c = lane & 7;
#pragma unroll
    for (int j = 0; j < 8; ++j) { const int nl = (lane >> 3) + 8 * j, n = n0 + nl; const LAS float* s = scr + (8 * c) * 65 + nl;
        v4u o; o.x = pk2(s[0 * 65] * g[0][0], s[1 * 65] * g[0][1]); o.y = pk2(s[2 * 65] * g[0][2], s[3 * 65] * g[0][3]); o.z = pk2(s[4 * 65] * g[1][0], s[5 * 65] * g[1][1]); o.w = pk2(s[6 * 65] * g[1][2], s[7 * 65] * g[1][3]);
        if (n < it.N) *(v4u*)(it.WT + (size_t)dst_row(it.kind, n) * it.K + k0 + 8 * c) = o; }
    LDS_WAIT(); asm volatile("" ::: "memory");
}
constexpr int I_GU = 32 * 176, I_DN = 88 * 32, I_IN = 32 * 97, I_OUT = 32 * 32, I_LAYER = 2 * I_GU + 2 * I_DN + I_IN + I_OUT;
DI CvItem cv_decode(const float* g1, const float* d1, const float* wi, const float* wo, const float* g2, const float* d2, const float* n1, const float* nm, const float* n2, unsigned char* wbase, int g) {
    const int l = g / I_LAYER; int r = g - l * I_LAYER; unsigned char* wl = wbase + (size_t)l * W_LAYER;
    if (r < I_GU) return CvItem{g1 + (size_t)l * D * NGU, (bf16*)(wl + WO_GU1), D, NGU, 1, r / 176, r % 176, n1 + (size_t)l * D}; r -= I_GU;
    if (r < I_DN) return CvItem{d1 + (size_t)l * FF * D, (bf16*)(wl + WO_DN1), FF, D, 0, r / 32, r % 32, nullptr}; r -= I_DN;
    if (r < I_IN) return CvItem{wi + (size_t)l * D * NIN, (bf16*)(wl + WO_IN), D, NIN, 0, r / 97, r % 97, nm + (size_t)l * D}; r -= I_IN;
    if (r < I_OUT) return CvItem{wo + (size_t)l * D * D, (bf16*)(wl + WO_OUT), D, D, 0, r / 32, r % 32, nullptr}; r -= I_OUT;
    if (r < I_GU) return CvItem{g2 + (size_t)l * D * NGU, (bf16*)(wl + WO_GU2), D, NGU, 1, r / 176, r % 176, n2 + (size_t)l * D}; r -= I_GU;
    return CvItem{d2 + (size_t)l * FF * D, (bf16*)(wl + WO_DN2), FF, D, 0, r / 32, r % 32, nullptr};
}
DI void convert_range(const float* g1, const float* d1, const float* wi, const float* wo, const float* g2, const float* d2, const float* n1, const float* nm, const float* n2, unsigned char* wl, int ib, int ie, int widx, int wstride, LAS float* scr, int lane) {
    int it = ib + widx; if (it >= ie) return;
    CvItem cur = cv_decode(g1, d1, wi, wo, g2, d2, n1, nm, n2, wl, it), nx = cur; f32x4 va[16], vb[16], ga[2], gb[2];
    cv_load(cur, lane, va, ga);
    for (;;) {
        bool has = it + wstride < ie;
        if (has) { nx = cv_decode(g1, d1, wi, wo, g2, d2, n1, nm, n2, wl, it + wstride); cv_load(nx, lane, vb, gb); }
        cv_finish(cur, va, ga, scr, lane);
        if (!has) break;
        it += wstride; cur = nx;
        has = it + wstride < ie;
        if (has) { nx = cv_decode(g1, d1, wi, wo, g2, d2, n1, nm, n2, wl, it + wstride); cv_load(nx, lane, va, ga); }
        cv_finish(cur, vb, gb, scr, lane);
        if (!has) break;
        it += wstride; cur = nx;
    }
}

template <int MODE>
DI bool norm_load(int row, const GAS float* xp, const GAS float* xs, const GAS float* meta, GAS bf16* h, GAS float* rs, const GAS float* slabs, float scale, LAS int* tmap, int lane, f32x4 (&v)[8]) {
    if (row >= TP) return false;
    if (row >= T_REAL) {
        if (MODE != 2) {
#pragma unroll
            for (int j = 0; j < 8; ++j) { if (MODE == 1) ((GAS v2u*)(h + (size_t)row * D))[lane + 64 * j] = (v2u){0u, 0u}; }
            if (lane == 0) rs[row] = 0.f;
        }
        return false;
    }
    if (MODE == 2 && row >= R_META) return false;
    if (MODE == 1) {
        const GAS float* src = row < R_SAMPLE ? xp + (size_t)row * D : (row < R_META ? xs + (size_t)(row - R_SAMPLE) * D : meta + (size_t)((row - R_META) & 15) * D);
#pragma unroll
        for (int j = 0; j < 8; ++j) v[j] = __builtin_nontemporal_load((const GAS f32x4*)src + lane + 64 * j);
    } else {
        v2u w[8];
#pragma unroll
        for (int j = 0; j < 8; ++j) w[j] = ((const GAS v2u*)(h + (size_t)row * D))[lane + 64 * j];
#pragma unroll
        for (int j = 0; j < 8; ++j) v[j] = (f32x4){bflo(w[j].x), bfhi(w[j].x), bflo(w[j].y), bfhi(w[j].y)};
    }
    if (MODE != 1) {
#pragma unroll
        for (int j = 0; j < 8; ++j) {
            const int tu = __builtin_amdgcn_readfirstlane(tmap[(row >> 8) * 8 + j]);
            if (tu >= 0) { const GAS bf16* sp = (const GAS bf16*)slabs + (size_t)tu * TSP * 65536 + (size_t)(row & 255) * 256 + 4 * lane; f32x4 a = (f32x4){0.f, 0.f, 0.f, 0.f};
#pragma unroll
                for (int ks = 0; ks < TSP; ++ks) { const v2u w2 = __builtin_nontemporal_load((const GAS v2u*)(sp + (size_t)ks * 65536)); a += (f32x4){bflo(w2.x), bfhi(w2.x), bflo(w2.y), bfhi(w2.y)}; }
                v[j] += a * scale;
                if (MODE == 0) ((GAS v2u*)(h + (size_t)row * D))[lane + 64 * j] = (v2u){pk2(v[j][0], v[j][1]), pk2(v[j][2], v[j][3])}; }
        }
    }
    return true;
}
template <int MODE>
DI void norm_finish(int row, const f32x4 (&v)[8], GAS bf16* h, const GAS float* gain, GAS float* rs, GAS float* out, int lane) {
    float ss = 0.f;
#pragma unroll
    for (int j = 0; j < 8; ++j) ss += (v[j][0] * v[j][0] + v[j][1] * v[j][1]) + (v[j][2] * v[j][2] + v[j][3] * v[j][3]);
    const float rstd = 1.0f / sqrtf(wave_sum(ss) * (1.0f / D) + EPS);
    if (MODE == 2) {
        GAS float* o = out + (row < R_SAMPLE ? O_YP + (size_t)row * D : O_YS + (size_t)(row - R_SAMPLE) * D);
#pragma unroll
        for (int j = 0; j < 8; ++j) __builtin_nontemporal_store(v[j] * rstd * ((const GAS f32x4*)gain)[lane + 64 * j], (GAS f32x4*)o + lane + 64 * j);
    } else {
        if (lane == 0) rs[row] = rstd;
        if (MODE == 1) {
#pragma unroll
            for (int j = 0; j < 8; ++j) ((GAS v2u*)(h + (size_t)row * D))[lane + 64 * j] = (v2u){pk2(v[j][0], v[j][1]), pk2(v[j][2], v[j][3])};
        }
    }
}
template <int MODE>
DI void norm_phase(const float* xp_, const float* xs_, const float* meta_, bf16* h_, const float* __restrict__ gain_, float* rs_, float* out_, int gw, int NGW, int lane,
                   const float* slabs_, float scale, int Kprev, int G, LAS unsigned char* lds, int tid) {
    const GAS float* xp = (const GAS float*)xp_; const GAS float* xs = (const GAS float*)xs_; const GAS float* meta = (const GAS float*)meta_; GAS bf16* h = (GAS bf16*)h_;
    const GAS float* gain = (const GAS float*)gain_; GAS float* rs = (GAS float*)rs_; GAS float* out = (GAS float*)out_; const GAS float* slabs = (const GAS float*)slabs_;
    LAS int* tmap = (LAS int*)lds;
    if (MODE != 1) {
        for (int i = tid; i < (TP / 256) * 8; i += NWAVES * 64) tmap[i] = -1;
        __syncthreads();
        pg8::TailSplitOrder<TSP> S; S.init(TP, D, Kprev, G, 0);
        const int nt = S.ntail(); const bool split = nt > 0 && nt * TSP <= G && (S.nkt % (2 * TSP)) == 0;
        if (split && tid < nt) { pg8::Unit u; if (S.tail_unit(tid, u)) tmap[u.pm * 8 + u.pn] = tid; }
        __syncthreads();
    }
    for (int row = gw; row < TP; row += NGW) {
        f32x4 va[8];
        if (norm_load<MODE>(row, xp, xs, meta, h, rs, slabs, scale, tmap, lane, va)) norm_finish<MODE>(row, va, h, gain, rs, out, lane);
    }
}

DI void cvt16(const v4u a, const v4u b, float (&f)[16]) {
    f[0] = bflo(a.x); f[1] = bfhi(a.x); f[2] = bflo(a.y); f[3] = bfhi(a.y); f[4] = bflo(a.z); f[5] = bfhi(a.z); f[6] = bflo(a.w); f[7] = bfhi(a.w);
    f[8] = bflo(b.x); f[9] = bfhi(b.x); f[10] = bflo(b.y); f[11] = bfhi(b.y); f[12] = bflo(b.z); f[13] = bfhi(b.z); f[14] = bflo(b.w); f[15] = bfhi(b.w); }
DI void conv_phase(const bf16* proj_, bf16* ymix_, const float* __restrict__ cw_, const float* __restrict__ cg_, const float* __restrict__ sconv_  , float* out_, int l, int gw, int NGW, int lane) {
    const GAS bf16* proj = (const GAS bf16*)proj_; GAS bf16* ymix = (GAS bf16*)ymix_; const GAS float* cw = (const GAS float*)cw_; const GAS float* cg = (const GAS float*)cg_;
    const GAS float* sconv = (const GAS float*)sconv_; GAS float* out = (GAS float*)out_;
    const int c0 = 16 * lane;
    constexpr int NRUN = 4 * 516 + 128 * 2;
    for (int ri = gw; ri < NRUN; ri += NGW) {
        const bool isp = ri < 4 * 516; const int sq = isp ? ri / 516 : (ri - 4 * 516) >> 1, p0 = isp ? 4 * (ri - sq * 516) : 4 * ((ri - 4 * 516) & 1);
#define CONV_ROW(pos) (isp ? row_prompt(sq, (pos)) : R_SAMPLE + sq * 8 + (pos))
        float u1[16], u2[16], t[16];
        if (p0 > 0) { v4u hc[2][2], hh[2][2];
#pragma unroll
            for (int k = 0; k < 2; ++k) { const GAS bf16* pr = proj + (size_t)CONV_ROW(p0 - 2 + k) * NINP + c0;
                hc[k][0] = *(const GAS v4u*)(pr + PC_C); hc[k][1] = *(const GAS v4u*)(pr + PC_C + 8); hh[k][0] = *(const GAS v4u*)(pr + PC_H); hh[k][1] = *(const GAS v4u*)(pr + PC_H + 8); }
            cvt16(hc[0][0], hc[0][1], u2); cvt16(hh[0][0], hh[0][1], t);
#pragma unroll
            for (int i = 0; i < 16; ++i) u2[i] *= t[i];
            cvt16(hc[1][0], hc[1][1], u1); cvt16(hh[1][0], hh[1][1], t);
#pragma unroll
            for (int i = 0; i < 16; ++i) u1[i] *= t[i];
        } else if (!isp) {
#pragma unroll
            for (int i = 0; i < 4; ++i) { const f32x4 s0 = *(const GAS f32x4*)(sconv + ((size_t)sq * 2 + 0) * DCONV + c0 + 4 * i), s1 = *(const GAS f32x4*)(sconv + ((size_t)sq * 2 + 1) * DCONV + c0 + 4 * i);
#pragma unroll
                for (int e = 0; e < 4; ++e) { u2[4 * i + e] = s0[e]; u1[4 * i + e] = s1[e]; } }
        } else {
#pragma unroll
            for (int i = 0; i < 16; ++i) { u2[i] = 0.f; u1[i] = 0.f; }
        }
        f32x4 cw0[4], cw1[4], cw2[4], cgv[4];
#pragma unroll
        for (int i = 0; i < 4; ++i) { cw0[i] = *(const GAS f32x4*)(cw + c0 + 4 * i); cw1[i] = *(const GAS f32x4*)(cw + DCONV + c0 + 4 * i); cw2[i] = *(const GAS f32x4*)(cw + 2 * DCONV + c0 + 4 * i); cgv[i] = *(const GAS f32x4*)(cg + c0 + 4 * i); }
        v4u nb[2], nc[2], nh[2];
        { const GAS bf16* pr = proj + (size_t)CONV_ROW(p0) * NINP + c0;
          nb[0] = *(const GAS v4u*)(pr + PC_B); nb[1] = *(const GAS v4u*)(pr + PC_B + 8); nc[0] = *(const GAS v4u*)(pr + PC_C); nc[1] = *(const GAS v4u*)(pr + PC_C + 8); nh[0] = *(const GAS v4u*)(pr + PC_H); nh[1] = *(const GAS v4u*)(pr + PC_H + 8); }
#pragma unroll
        for (int k = 0; k < 4; ++k) {
            const int pos = p0 + k, row = CONV_ROW(pos);
            float cb[16], u0[16], y[16], w[16];
            cvt16(nb[0], nb[1], cb); cvt16(nc[0], nc[1], u0); cvt16(nh[0], nh[1], t);
            if (k < 3) { const GAS bf16* pr = proj + (size_t)CONV_ROW(pos + 1) * NINP + c0;
                nb[0] = *(const GAS v4u*)(pr + PC_B); nb[1] = *(const GAS v4u*)(pr + PC_B + 8); nc[0] = *(const GAS v4u*)(pr + PC_C); nc[1] = *(const GAS v4u*)(pr + PC_C + 8); nh[0] = *(const GAS v4u*)(pr + PC_H); nh[1] = *(const GAS v4u*)(pr + PC_H + 8); }
#pragma unroll
            for (int i = 0; i < 16; ++i) u0[i] *= t[i];
            float ss = 0.f;
#pragma unroll
            for (int i = 0; i < 4; ++i) { const f32x4 w0 = cw0[i], w1 = cw1[i], w2 = cw2[i];
#pragma unroll
                for (int e = 0; e < 4; ++e) { const int j = 4 * i + e; y[j] = cb[j] * (w0[e] * u2[j] + w1[e] * u1[j] + w2[e] * u0[j]); ss += y[j] * y[j]; } }
            ss += __shfl_xor(ss, 1); ss += __shfl_xor(ss, 2); ss += __shfl_xor(ss, 4);
            const float rs = 1.0f / sqrtf(ss * (1.0f / 128.0f) + EPS);
#pragma unroll
            for (int i = 0; i < 4; ++i) { const f32x4 g4 = cgv[i]; w[4 * i] = g4[0]; w[4 * i + 1] = g4[1]; w[4 * i + 2] = g4[2]; w[4 * i + 3] = g4[3]; }
            v4u o0, o1;
            o0.x = pk2(y[0] * rs * w[0], y[1] * rs * w[1]); o0.y = pk2(y[2] * rs * w[2], y[3] * rs * w[3]); o0.z = pk2(y[4] * rs * w[4], y[5] * rs * w[5]); o0.w = pk2(y[6] * rs * w[6], y[7] * rs * w[7]);
            o1.x = pk2(y[8] * rs * w[8], y[9] * rs * w[9]); o1.y = pk2(y[10] * rs * w[10], y[11] * rs * w[11]); o1.z = pk2(y[12] * rs * w[12], y[13] * rs * w[13]); o1.w = pk2(y[14] * rs * w[14], y[15] * rs * w[15]);
            GAS bf16* yo = ymix + (size_t)row * D + c0; ((GAS v4u*)yo)[0] = o0; ((GAS v4u*)yo)[1] = o1;
            GAS float* uo = nullptr;
            if (isp) { if (pos >= 2062) uo = out + O_CP + ((size_t)(l * 4 + sq) * 2 + (pos - 2062)) * DCONV; }
            else if (pos >= 6) uo = out + O_CS + ((size_t)(l * 128 + sq) * 2 + (pos - 6)) * DCONV;
            if (uo) {
#pragma unroll
                for (int i = 0; i < 4; ++i) ((GAS f32x4*)(uo + c0))[i] = (f32x4){u0[4 * i], u0[4 * i + 1], u0[4 * i + 2], u0[4 * i + 3]}; }
#pragma unroll
            for (int i = 0; i < 16; ++i) { u2[i] = u1[i]; u1[i] = u0[i]; }
        }
#undef CONV_ROW
    }
}

typedef short bf16x8 __attribute__((ext_vector_type(8)));
DI unsigned pkbf(float lo, float hi) { f32x2 v = {lo, hi}; bf16x2_t r = __builtin_convertvector(v, bf16x2_t); return __builtin_bit_cast(unsigned, r); }
DI bf16x8 mk8(v2u lo, v2u hi) { v4u t = {lo.x, lo.y, hi.x, hi.y}; return __builtin_bit_cast(bf16x8, t); }
DI void tr2(unsigned a0, unsigned a1, v2u& r0, v2u& r1) {
    asm volatile("ds_read_b64_tr_b16 %0, %2\n\tds_read_b64_tr_b16 %1, %3\n\ts_waitcnt lgkmcnt(0)" : "=&v"(r0), "=&v"(r1) : "v"(a0), "v"(a1) : "memory");
}
#define LBAR() do { asm volatile("s_waitcnt lgkmcnt(0)" ::: "memory"); __builtin_amdgcn_s_barrier(); asm volatile("" ::: "memory"); } while (0)
constexpr int GS_QK = 272, GS_V = 528, GS_P = 144, GS_O = 1040;
constexpr int GL_QS = 0, GL_KD = 17408, GL_KL = 34816, GL_V = 52224, GL_PL = 86016, GL_FL = 95232, GL_GT = 99328, GL_EBL = 103424, GL_OL = 0;
DI int chunk_row(bool is_prompt, int bidx, int c, int t) {
    if (is_prompt) { if (c == 0) return t >= 48 ? R_META + 16 * bidx + (t - 48) : -1; return 2048 * bidx + 64 * (c - 1) + t; }
    return t >= 56 ? R_SAMPLE + 8 * bidx + (t - 56) : -1;
}
DI float logsig16(float x) { return (fminf(x, 0.f) - __logf(1.0f + __expf(-fabsf(x)))) * (1.0f / 16.0f); }

#define GLA_LANES() int tid = w * 64 + fresh_lane(); asm volatile("" : "+v"(tid)); const int lane = tid & 63, r = lane & 15, q = lane >> 4, dp = lane, c8 = tid & 31; (void)r; (void)q; (void)dp; (void)c8;
DI void gla_out_stage(LAS unsigned char* lds, const GAS bf16* proj, GAS bf16* ymix, const GAS float* __restrict__ gg, int hd, bool is_prompt, int bidx, int c, const int w) {
    GLA_LANES();
    const f32x4 ggA = *(const GAS f32x4*)(gg + 8 * c8), ggB = *(const GAS f32x4*)(gg + 8 * c8 + 4);
    v4u gw4[4]; int rows[4];
#pragma unroll
    for (int ps = 0; ps < 4; ++ps) { rows[ps] = chunk_row(is_prompt, bidx, c, 16 * ps + (tid >> 5)); const int rc = rows[ps] < 0 ? 0 : rows[ps];
        gw4[ps] = *(const GAS v4u*)(proj + (size_t)rc * NINP + PC_GO + 256 * hd + 8 * c8); }
#pragma unroll
    for (int ps = 0; ps < 4; ++ps) { const int t = 16 * ps + (tid >> 5); const LAS unsigned char* op = lds + GL_OL + t * GS_O + 32 * c8;
        const f32x4 oa = *(const LAS f32x4*)op, ob = *(const LAS f32x4*)(op + 16);
        float ss = (oa[0] * oa[0] + oa[1] * oa[1]) + (oa[2] * oa[2] + oa[3] * oa[3]) + (ob[0] * ob[0] + ob[1] * ob[1]) + (ob[2] * ob[2] + ob[3] * ob[3]);
        ss += __shfl_xor(ss, 1); ss += __shfl_xor(ss, 2); ss += __shfl_xor(ss, 4); ss += __shfl_xor(ss, 8); ss += __shfl_xor(ss, 16);
        const float rs = 1.0f / sqrtf(ss * (1.0f / 256.0f) + EPS);
        if (rows[ps] >= 0) { const v4u g4 = gw4[ps];
            const float gv[8] = {bflo(g4.x), bfhi(g4.x), bflo(g4.y), bfhi(g4.y), bflo(g4.z), bfhi(g4.z), bflo(g4.w), bfhi(g4.w)}; float y[8];
#pragma unroll
            for (int e = 0; e < 4; ++e) { y[e] = oa[e] * rs * ggA[e] * (gv[e] / (1.0f + __expf(-gv[e]))); y[4 + e] = ob[e] * rs * ggB[e] * (gv[4 + e] / (1.0f + __expf(-gv[4 + e]))); }
            *(GAS v4u*)(ymix + (size_t)rows[ps] * D + DCONV + 256 * hd + 8 * c8) = (v4u){pkbf(y[0], y[1]), pkbf(y[2], y[3]), pkbf(y[4], y[5]), pkbf(y[6], y[7])}; } }
}

DI void gla_sample_item(LAS unsigned char* lds, const GAS bf16* proj, GAS bf16* ymix, const GAS float* __restrict__ fw2, const GAS float* __restrict__ fb, const GAS float* __restrict__ gg,
                        int hd, int sb, const GAS float* S_in, GAS float* S_out, const int w) {
    const int lane = fresh_lane();
    LAS float* L_Q = (LAS float*)(lds + 0);
    LAS float* L_K = (LAS float*)(lds + 4096);
    LAS float* L_DEC = (LAS float*)(lds + 8192);
    LAS float* L_V = (LAS float*)(lds + 12288);
    LAS float* L_PART = (LAS float*)(lds + 20480);
    const int row = R_SAMPLE + sb * 8 + w;
    const GAS bf16* pr = proj + (size_t)row * NINP;
    f32x4 S[16];
#pragma unroll
    for (int i = 0; i < 16; ++i) S[i] = __builtin_nontemporal_load((const GAS f32x4*)(S_in + (size_t)(16 * w + i) * GDV) + lane);
    const v2u gw2 = *(const GAS v2u*)(pr + PC_GO + 256 * hd + 4 * lane);
    const f32x4 ggv = ((const GAS f32x4*)gg)[lane];
    {
        f32x2 fwa[16];
#pragma unroll
        for (int r = 0; r < 16; ++r) fwa[r] = *(const GAS f32x2*)(fw2 + r * 512 + 128 * hd + 2 * lane);
        const v4u f0 = *(const GAS v4u*)(pr + PC_FL), f1 = *(const GAS v4u*)(pr + PC_FL + 8);
        const f32x2 fbv = *(const GAS f32x2*)(fb + 128 * hd + 2 * lane);
        const unsigned qw = *(const GAS unsigned*)(pr + PC_Q + 128 * hd + 2 * lane), kw = *(const GAS unsigned*)(pr + PC_K + 128 * hd + 2 * lane);
        const v2u vw = *(const GAS v2u*)(pr + PC_V + 256 * hd + 4 * lane);
        __builtin_amdgcn_sched_barrier(0);
        const float fl[16] = {bflo(f0.x), bfhi(f0.x), bflo(f0.y), bfhi(f0.y), bflo(f0.z), bfhi(f0.z), bflo(f0.w), bfhi(f0.w), bflo(f1.x), bfhi(f1.x), bflo(f1.y), bfhi(f1.y), bflo(f1.z), bfhi(f1.z), bflo(f1.w), bfhi(f1.w)};
        float x0 = fbv[0], x1 = fbv[1];
#pragma unroll
        for (int r = 0; r < 16; ++r) { x0 += fl[r] * fwa[r][0]; x1 += fl[r] * fwa[r][1]; }
        const float qs = 0.08838834764831845f;
        *(LAS f32x2*)(L_Q + w * 128 + 2 * lane) = (f32x2){bflo(qw) * qs, bfhi(qw) * qs};
        *(LAS f32x2*)(L_K + w * 128 + 2 * lane) = (f32x2){bflo(kw), bfhi(kw)};
        *(LAS f32x2*)(L_DEC + w * 128 + 2 * lane) = (f32x2){__expf(logsig16(x0)), __expf(logsig16(x1))};
        *(LAS f32x4*)(L_V + w * 256 + 4 * lane) = (f32x4){bflo(vw.x), bfhi(vw.x), bflo(vw.y), bfhi(vw.y)};
    }
    LBAR();
#pragma unroll 2
    for (int t = 0; t < 8; ++t) {
        const f32x4 vv = *(const LAS f32x4*)(L_V + t * 256 + 4 * lane);
        f32x4 po = (f32x4){0.f, 0.f, 0.f, 0.f};
#pragma unroll
        for (int i4 = 0; i4 < 4; ++i4) {
            const f32x4 dq = *(const LAS f32x4*)(L_DEC + t * 128 + 16 * w + 4 * i4), kq = *(const LAS f32x4*)(L_K + t * 128 + 16 * w + 4 * i4), qq = *(const LAS f32x4*)(L_Q + t * 128 + 16 * w + 4 * i4);
#pragma unroll
            for (int e = 0; e < 4; ++e) { const int i = 4 * i4 + e; S[i] = S[i] * dq[e] + vv * kq[e]; po += S[i] * qq[e]; }
        }
        *(LAS f32x4*)(L_PART + (t * 8 + w) * 256 + 4 * lane) = po;
    }
#pragma unroll
    for (int i = 0; i < 16; ++i) __builtin_nontemporal_store(S[i], (GAS f32x4*)(S_out + (size_t)(16 * w + i) * GDV) + lane);
    LBAR();
    {
        f32x4 o = (f32x4){0.f, 0.f, 0.f, 0.f};
#pragma unroll
        for (int ww = 0; ww < 8; ++ww) o += *(const LAS f32x4*)(L_PART + (w * 8 + ww) * 256 + 4 * lane);
        const float ss = wave_sum((o[0] * o[0] + o[1] * o[1]) + (o[2] * o[2] + o[3] * o[3]));
        const float rs = 1.0f / sqrtf(ss * (1.0f / 256.0f) + EPS);
        const float gv[4] = {bflo(gw2.x), bfhi(gw2.x), bflo(gw2.y), bfhi(gw2.y)}; float y[4];
#pragma unroll
        for (int e = 0; e < 4; ++e) y[e] = o[e] * rs * ggv[e] * (gv[e] / (1.0f + __expf(-gv[e])));
        *(GAS v2u*)(ymix + (size_t)row * D + DCONV + 256 * hd + 4 * lane) = (v2u){pkbf(y[0], y[1]), pkbf(y[2], y[3])};
    }
    LBAR();
}

DI void gla_item_mfma(LAS unsigned char* lds, const GAS bf16* proj, GAS bf16* ymix, const GAS float* __restrict__ fw2, const GAS float* __restrict__ fb, const GAS float* __restrict__ gg,
                      int hd, bool is_prompt, int bidx, int c0, const GAS float* S_in, GAS float* S_out, const int w,
                      GAS bf16* gqs, GAS bf16* gpl, GAS float* gebl, GAS float* gu) {
    const int tg = w;
#define GLA_LOAD_QK(c, DP) do { \
        _Pragma("unroll") for (int i = 0; i < 8; ++i) { const int row_ = chunk_row(is_prompt, bidx, (c), 8 * tg + i); const int rc_ = row_ < 0 ? 0 : row_; \
            const GAS bf16* p_ = proj + (size_t)rc_ * NINP + 128 * hd + 2 * (DP); const unsigned qv_ = *(const GAS unsigned*)(p_ + PC_Q), kv_ = *(const GAS unsigned*)(p_ + PC_K); qw[i] = row_ < 0 ? 0u : qv_; kw[i] = row_ < 0 ? 0u : kv_; } \
    } while (0)
#define GLA_LOAD_V(c) do { \
        _Pragma("unroll") for (int i = 0; i < 4; ++i) { const int row_ = chunk_row(is_prompt, bidx, (c), (tid >> 5) + 16 * i); const int rc_ = row_ < 0 ? 0 : row_; \
            const v4u vv_ = *(const GAS v4u*)(proj + (size_t)rc_ * NINP + PC_V + 256 * hd + 8 * c8); vr[i] = row_ < 0 ? (v4u){0u, 0u, 0u, 0u} : vv_; } \
        { const int row_ = chunk_row(is_prompt, bidx, (c), (tid >> 1) & 63); const int rc_ = row_ < 0 ? 0 : row_; const v4u ff_ = *(const GAS v4u*)(proj + (size_t)rc_ * NINP + PC_FL + 8 * (tid & 1)); flr = row_ < 0 ? (v4u){0u, 0u, 0u, 0u} : ff_; } \
    } while (0)
    {
        const int c = c0;
        const int tmin = is_prompt ? (c == 0 ? 48 : 0) : 56;
        {
            GLA_LANES();
            v4u vr[4]; v4u flr;
            GLA_LOAD_V(c);
#pragma unroll
            for (int i = 0; i < 4; ++i) *(LAS v4u*)(lds + GL_V + ((tid >> 5) + 16 * i) * GS_V + 16 * c8) = vr[i];
            if (tid < 128) { LAS float* f = (LAS float*)(lds + GL_FL) + (tid >> 1) * 16 + 8 * (tid & 1);
                *(LAS f32x4*)f = (f32x4){bflo(flr.x), bfhi(flr.x), bflo(flr.y), bfhi(flr.y)}; *(LAS f32x4*)(f + 4) = (f32x4){bflo(flr.z), bfhi(flr.z), bflo(flr.w), bfhi(flr.w)}; }
        }
        LBAR();
        {
            const int dpa = fresh_lane();
            const f32x2 fbv = *(const GAS f32x2*)(fb + 128 * hd + 2 * dpa);
            unsigned qw[8], kw[8];
            GLA_LOAD_QK(c, dpa);
            float c0[8], c1[8]; float run0 = 0.f, run1 = 0.f;
#pragma unroll
            for (int i = 0; i < 8; ++i) { c0[i] = fbv[0]; c1[i] = fbv[1]; }
#pragma unroll
            for (int j = 0; j < 4; ++j) { f32x2 fwj[4];
#pragma unroll
                for (int e = 0; e < 4; ++e) fwj[e] = *(const GAS f32x2*)(fw2 + (4 * j + e) * 512 + 128 * hd + 2 * dpa);
#pragma unroll
                for (int i = 0; i < 8; ++i) { const f32x4 f = ((const LAS f32x4*)(lds + GL_FL))[(8 * tg + i) * 4 + j];
#pragma unroll
                    for (int e = 0; e < 4; ++e) { c0[i] += f[e] * fwj[e][0]; c1[i] += f[e] * fwj[e][1]; } }
                __builtin_amdgcn_sched_barrier(0); }
#pragma unroll
            for (int i = 0; i < 8; ++i) { const bool valid = (8 * tg + i) >= tmin;
                run0 += valid ? logsig16(c0[i]) : 0.f; run1 += valid ? logsig16(c1[i]) : 0.f; c0[i] = run0; c1[i] = run1; if (i & 1) __builtin_amdgcn_sched_barrier(0); }
            { const int dp2 = fresh_lane(); *(LAS f32x2*)(lds + GL_GT + (tg * 128 + 2 * dp2) * 4) = (f32x2){run0, run1}; }
            LBAR();
            const int dp = fresh_lane();
            float off0 = 0.f, off1 = 0.f, tot0 = 0.f, tot1 = 0.f;
#pragma unroll
            for (int g8 = 0; g8 < 8; ++g8) { const f32x2 v = *(const LAS f32x2*)(lds + GL_GT + (g8 * 128 + 2 * dp) * 4); tot0 += v[0]; tot1 += v[1]; if (g8 < tg) { off0 += v[0]; off1 += v[1]; } }
#pragma unroll
            for (int i = 0; i < 8; ++i) { const int t = 8 * tg + i; const float b0 = off0 + c0[i], b1 = off1 + c1[i];
                const float eb0 = __expf(b0), eb1 = __expf(b1), en0 = __expf(-b0), en1 = __expf(-b1), el0 = __expf(tot0 - b0), el1 = __expf(tot1 - b1);
                const float q0 = bflo(qw[i]) * 0.08838834764831845f, q1 = bfhi(qw[i]) * 0.08838834764831845f, k0 = bflo(kw[i]), k1 = bfhi(kw[i]);
                *(LAS unsigned*)(lds + GL_QS + t * GS_QK + 4 * dp) = pkbf(q0 * eb0, q1 * eb1);
                *(LAS unsigned*)(lds + GL_KD + t * GS_QK + 4 * dp) = pkbf(k0 * en0, k1 * en1);
                *(LAS unsigned*)(lds + GL_KL + t * GS_QK + 4 * dp) = pkbf(k0 * el0, k1 * el1); if (i & 1) __builtin_amdgcn_sched_barrier(0); }
            if (tg == 0) *(LAS f32x2*)(lds + GL_EBL + 8 * dp) = (f32x2){__expf(tot0), __expf(tot1)};
        }
        LBAR();
        {
            GLA_LANES();
#pragma unroll
            for (int j2 = 0; j2 < 2; ++j2) { const int idx = 2 * w + j2, st = idx >> 2, tt = idx & 3;
                f32x4 acc = (f32x4){0.f, 0.f, 0.f, 0.f};
                if (st <= tt) {
#pragma unroll
                    for (int ks = 0; ks < 4; ++ks) { const bf16x8 a = *(const LAS bf16x8*)(lds + GL_KD + (16 * st + r) * GS_QK + (32 * ks + 8 * q) * 2), b = *(const LAS bf16x8*)(lds + GL_QS + (16 * tt + r) * GS_QK + (32 * ks + 8 * q) * 2);
                        acc = __builtin_amdgcn_mfma_f32_16x16x32_bf16(a, b, acc, 0, 0, 0); }
                }
                const int tq = 16 * tt + r, s0 = 16 * st + 4 * q;
                const float p0 = (s0 + 0 <= tq) ? acc[0] : 0.f, p1 = (s0 + 1 <= tq) ? acc[1] : 0.f, p2 = (s0 + 2 <= tq) ? acc[2] : 0.f, p3 = (s0 + 3 <= tq) ? acc[3] : 0.f;
                *(LAS v2u*)(lds + GL_PL + tq * GS_P + s0 * 2) = (v2u){pkbf(p0, p1), pkbf(p2, p3)}; }
        }
        LBAR();
        if (is_prompt) {
            GLA_LANES();
            const unsigned lbase = (unsigned)(uintptr_t)lds;
            bf16x8 Vf[2][2];
#pragma unroll
            for (int ks = 0; ks < 2; ++ks)
#pragma unroll
                for (int vt = 0; vt < 2; ++vt) { const unsigned a0 = lbase + GL_V + (32 * ks + 8 * q + (r >> 2)) * GS_V + (32 * w + 16 * vt + 4 * (r & 3)) * 2; v2u lo, hi; tr2(a0, a0 + 4 * GS_V, lo, hi); Vf[ks][vt] = mk8(lo, hi); }
#pragma unroll
            for (int dt = 0; dt < 8; ++dt) { f32x4 C0 = (f32x4){0.f, 0.f, 0.f, 0.f}, C1 = (f32x4){0.f, 0.f, 0.f, 0.f};
#pragma unroll
                for (int ks = 0; ks < 2; ++ks) { const unsigned a0 = lbase + GL_KL + (32 * ks + 8 * q + (r >> 2)) * GS_QK + (16 * dt + 4 * (r & 3)) * 2; v2u lo, hi; tr2(a0, a0 + 4 * GS_QK, lo, hi); const bf16x8 kl = mk8(lo, hi);
                    C0 = __builtin_amdgcn_mfma_f32_16x16x32_bf16(Vf[ks][0], kl, C0, 0, 0, 0); C1 = __builtin_amdgcn_mfma_f32_16x16x32_bf16(Vf[ks][1], kl, C1, 0, 0, 0); }
                GAS bf16* up = (GAS bf16*)gu + (size_t)(16 * dt + r) * GDV + 32 * w + 4 * q; *(GAS v2u*)up = (v2u){pkbf(C0[0], C0[1]), pkbf(C0[2], C0[3])}; *(GAS v2u*)(up + 16) = (v2u){pkbf(C1[0], C1[1]), pkbf(C1[2], C1[3])}; __builtin_amdgcn_sched_barrier(0); }
            { const int row = tid >> 3, ch = tid & 7;
              const v4u a = *(const LAS v4u*)(lds + GL_QS + row * GS_QK + 32 * ch), b2 = *(const LAS v4u*)(lds + GL_QS + row * GS_QK + 32 * ch + 16);
              *(GAS v4u*)(gqs + row * 128 + 16 * ch) = a; *(GAS v4u*)(gqs + row * 128 + 16 * ch + 8) = b2;
              *(GAS v4u*)(gpl + row * 64 + 8 * ch) = *(const LAS v4u*)(lds + GL_PL + row * GS_P + 16 * ch);
              if (tid < 128) gebl[tid] = *(const LAS float*)(lds + GL_EBL + 4 * tid); }
            LBAR();
            return;
        }
        f32x4 O[4][2]; f32x4 Sacc[8][2];
        {
            GLA_LANES();
            { const GAS float* sp = S_in + (size_t)(4 * q) * GDV + 32 * w + r;
#pragma unroll
              for (int dt = 0; dt < 8; ++dt)
#pragma unroll
                  for (int vt = 0; vt < 2; ++vt)
#pragma unroll
                      for (int i = 0; i < 4; ++i) Sacc[dt][vt][i] = sp[(16 * dt + i) * GDV + 16 * vt]; }
            const unsigned lbase = (unsigned)(uintptr_t)lds;
#pragma unroll
            for (int tt = 0; tt < 4; ++tt) { O[tt][0] = (f32x4){0.f, 0.f, 0.f, 0.f}; O[tt][1] = (f32x4){0.f, 0.f, 0.f, 0.f}; }
#pragma unroll
            for (int ks = 0; ks < 4; ++ks) {
                bf16x8 Sb[2];
#pragma unroll
                for (int vt = 0; vt < 2; ++vt) { const f32x4 lo = Sacc[2 * ks][vt], hi = Sacc[2 * ks + 1][vt]; Sb[vt] = __builtin_bit_cast(bf16x8, (v4u){pkbf(lo[0], lo[1]), pkbf(lo[2], lo[3]), pkbf(hi[0], hi[1]), pkbf(hi[2], hi[3])}); }
#pragma unroll
                for (int tt = 0; tt < 4; ++tt) { const LAS unsigned char* qp = lds + GL_QS + (16 * tt + r) * GS_QK + (32 * ks + 4 * q) * 2;
                    const bf16x8 a = mk8(*(const LAS v2u*)qp, *(const LAS v2u*)(qp + 32));
                    O[tt][0] = __builtin_amdgcn_mfma_f32_16x16x32_bf16(a, Sb[0], O[tt][0], 0, 0, 0); O[tt][1] = __builtin_amdgcn_mfma_f32_16x16x32_bf16(a, Sb[1], O[tt][1], 0, 0, 0); }
                __builtin_amdgcn_sched_barrier(0);
            }
            bf16x8 Vf[2][2];
#pragma unroll
            for (int ks = 0; ks < 2; ++ks)
#pragma unroll
                for (int vt = 0; vt < 2; ++vt) { const unsigned a0 = lbase + GL_V + (32 * ks + 8 * q + (r >> 2)) * GS_V + (32 * w + 16 * vt + 4 * (r & 3)) * 2; v2u lo, hi; tr2(a0, a0 + 4 * GS_V, lo, hi); Vf[ks][vt] = mk8(lo, hi); }
#pragma unroll
            for (int ks = 0; ks < 2; ++ks)
#pragma unroll
                for (int tt = 0; tt < 4; ++tt) { const bf16x8 a = *(const LAS bf16x8*)(lds + GL_PL + (16 * tt + r) * GS_P + (32 * ks + 8 * q) * 2);
                    O[tt][0] = __builtin_amdgcn_mfma_f32_16x16x32_bf16(a, Vf[ks][0], O[tt][0], 0, 0, 0); O[tt][1] = __builtin_amdgcn_mfma_f32_16x16x32_bf16(a, Vf[ks][1], O[tt][1], 0, 0, 0); }
            __builtin_amdgcn_sched_barrier(0);
#pragma unroll
            for (int dt = 0; dt < 8; ++dt) { const f32x4 e4 = *(const LAS f32x4*)(lds + GL_EBL + (16 * dt + 4 * q) * 4);
                f32x4 C0 = Sacc[dt][0] * e4, C1 = Sacc[dt][1] * e4;
#pragma unroll
                for (int ks = 0; ks < 2; ++ks) { const unsigned a0 = lbase + GL_KL + (32 * ks + 8 * q + (r >> 2)) * GS_QK + (16 * dt + 4 * (r & 3)) * 2; v2u lo, hi; tr2(a0, a0 + 4 * GS_QK, lo, hi); const bf16x8 a = mk8(lo, hi);
                    C0 = __builtin_amdgcn_mfma_f32_16x16x32_bf16(a, Vf[ks][0], C0, 0, 0, 0); C1 = __builtin_amdgcn_mfma_f32_16x16x32_bf16(a, Vf[ks][1], C1, 0, 0, 0); }
                GAS float* so = S_out + (size_t)(16 * dt + 4 * q) * GDV + 32 * w + r;
#pragma unroll
                for (int i = 0; i < 4; ++i) { so[i * GDV] = C0[i]; so[i * GDV + 16] = C1[i]; }
                __builtin_amdgcn_sched_barrier(0); }
        }
        LBAR();
        {   GLA_LANES();
#pragma unroll
            for (int tt = 0; tt < 4; ++tt)
#pragma unroll
                for (int vt = 0; vt < 2; ++vt)
#pragma unroll
                    for (int i = 0; i < 4; ++i) *(LAS float*)(lds + GL_OL + (16 * tt + 4 * q + i) * GS_O + (32 * w + 16 * vt + r) * 4) = O[tt][vt][i];
        }
        LBAR();
        gla_out_stage(lds, proj, ymix, gg, hd, is_prompt, bidx, c, w);
        LBAR();
    }
#undef GLA_LOAD_QK
#undef GLA_LOAD_V
}

DI void gla_scan_phase(const GAS float* gu, const GAS float* gebl, GAS bf16* gs, GAS float* out_state, int gtid, int nthreads) {
    for (int e = gtid; e < 16 * 8192; e += nthreads) {
        const int bh = e >> 13, rem = e & 8191, d = rem >> 6, v = (rem & 63) * 4;
        f32x4 S = (f32x4){0.f, 0.f, 0.f, 0.f};
#pragma nounroll
        for (int c3 = 0; c3 < 33; c3 += 11) {
            f32x4 u[11]; float eb[11];
#pragma unroll
            for (int j = 0; j < 11; ++j) { const size_t idx = (size_t)bh * 33 + c3 + j; const v2u w2 = __builtin_nontemporal_load((const GAS v2u*)((const GAS bf16*)gu + (idx * GDK + d) * GDV + v)); u[j] = (f32x4){bflo(w2.x), bfhi(w2.x), bflo(w2.y), bfhi(w2.y)}; eb[j] = gebl[idx * GDK + d]; }
#pragma unroll
            for (int j = 0; j < 11; ++j) { const size_t idx = (size_t)bh * 33 + c3 + j;
                *(GAS v2u*)(gs + (idx * GDK + d) * GDV + v) = (v2u){pkbf(S[0], S[1]), pkbf(S[2], S[3])};
                S = S * eb[j] + u[j]; }
        }
        *(GAS f32x4*)(out_state + ((size_t)bh * GDK + d) * GDV + v) = S;
    }
}

constexpr int CS_S = 0, CS_QS = 67584, CS_PL = 84992, CS_V = 94208;
DI void gla_passC_item(LAS unsigned char* lds, const GAS bf16* proj, GAS bf16* ymix, const GAS float* __restrict__ gg, int hd, int bidx, int c, const int w,
                       const GAS bf16* gqs, const GAS bf16* gpl, const GAS bf16* gs) {
    {   GLA_LANES();
        v4u sr[8], qr[2], pr, vr[4];
        if (c != 0) {
#pragma unroll
            for (int i = 0; i < 8; ++i) sr[i] = __builtin_nontemporal_load((const GAS v4u*)(gs + (size_t)((tid >> 5) + 16 * i) * GDV + 8 * c8));
        }
        { const int row = tid >> 3, ch = tid & 7; qr[0] = __builtin_nontemporal_load((const GAS v4u*)(gqs + row * 128 + 16 * ch)); qr[1] = __builtin_nontemporal_load((const GAS v4u*)(gqs + row * 128 + 16 * ch + 8)); pr = __builtin_nontemporal_load((const GAS v4u*)(gpl + row * 64 + 8 * ch)); }
#pragma unroll
        for (int i = 0; i < 4; ++i) { const int row_ = chunk_row(true, bidx, c, (tid >> 5) + 16 * i); const int rc_ = row_ < 0 ? 0 : row_;
            const v4u vv_ = *(const GAS v4u*)(proj + (size_t)rc_ * NINP + PC_V + 256 * hd + 8 * c8); vr[i] = row_ < 0 ? (v4u){0u, 0u, 0u, 0u} : vv_; }
        if (c != 0) {
#pragma unroll
            for (int i = 0; i < 8; ++i) *(LAS v4u*)(lds + CS_S + ((tid >> 5) + 16 * i) * GS_V + 16 * c8) = sr[i];
        }
        { const int row = tid >> 3, ch = tid & 7; *(LAS v4u*)(lds + CS_QS + row * GS_QK + 32 * ch) = qr[0]; *(LAS v4u*)(lds + CS_QS + row * GS_QK + 32 * ch + 16) = qr[1]; *(LAS v4u*)(lds + CS_PL + row * GS_P + 16 * ch) = pr; }
#pragma unroll
        for (int i = 0; i < 4; ++i) *(LAS v4u*)(lds + CS_V + ((tid >> 5) + 16 * i) * GS_V + 16 * c8) = vr[i];
    }
    LBAR();
    f32x4 O[4][2];
    {   GLA_LANES();
        const unsigned lbase = (unsigned)(uintptr_t)lds;
#pragma unroll
        for (int tt = 0; tt < 4; ++tt) { O[tt][0] = (f32x4){0.f, 0.f, 0.f, 0.f}; O[tt][1] = (f32x4){0.f, 0.f, 0.f, 0.f}; }
        if (c != 0) {
#pragma unroll
        for (int ks = 0; ks < 4; ++ks) {
            bf16x8 Sf[2];
#pragma unroll
            for (int vt = 0; vt < 2; ++vt) { const unsigned a0 = lbase + CS_S + (32 * ks + 8 * q + (r >> 2)) * GS_V + (32 * w + 16 * vt + 4 * (r & 3)) * 2; v2u lo, hi; tr2(a0, a0 + 4 * GS_V, lo, hi); Sf[vt] = mk8(lo, hi); }
#pragma unroll
            for (int tt = 0; tt < 4; ++tt) { const bf16x8 a = *(const LAS bf16x8*)(lds + CS_QS + (16 * tt + r) * GS_QK + (32 * ks + 8 * q) * 2);
                O[tt][0] = __builtin_amdgcn_mfma_f32_16x16x32_bf16(a, Sf[0], O[tt][0], 0, 0, 0); O[tt][1] = __builtin_amdgcn_mfma_f32_16x16x32_bf16(a, Sf[1], O[tt][1], 0, 0, 0); }
            __builtin_amdgcn_sched_barrier(0);
        }
        }
#pragma unroll
        for (int ks = 0; ks < 2; ++ks) {
            bf16x8 Vf[2];
#pragma unroll
            for (int vt = 0; vt < 2; ++vt) { const unsigned a0 = lbase + CS_V + (32 * ks + 8 * q + (r >> 2)) * GS_V + (32 * w + 16 * vt + 4 * (r & 3)) * 2; v2u lo, hi; tr2(a0, a0 + 4 * GS_V, lo, hi); Vf[vt] = mk8(lo, hi); }
#pragma unroll
            for (int tt = 0; tt < 4; ++tt) { const bf16x8 a = *(const LAS bf16x8*)(lds + CS_PL + (16 * tt + r) * GS_P + (32 * ks + 8 * q) * 2);
                O[tt][0] = __builtin_amdgcn_mfma_f32_16x16x32_bf16(a, Vf[0], O[tt][0], 0, 0, 0); O[tt][1] = __builtin_amdgcn_mfma_f32_16x16x32_bf16(a, Vf[1], O[tt][1], 0, 0, 0); }
            __builtin_amdgcn_sched_barrier(0);
        }
    }
    LBAR();
    {   GLA_LANES();
#pragma unroll
        for (int tt = 0; tt < 4; ++tt)
#pragma unroll
            for (int vt = 0; vt < 2; ++vt)
#pragma unroll
                for (int i = 0; i < 4; ++i) *(LAS float*)(lds + GL_OL + (16 * tt + 4 * q + i) * GS_O + (32 * w + 16 * vt + r) * 4) = O[tt][vt][i];
    }
    LBAR();
    gla_out_stage(lds, proj, ymix, gg, hd, true, bidx, c, w);
    LBAR();
}
#undef GLA_LANES

struct Args { const float* in[20]; float* out; unsigned char* ws; int ph_lo, ph_hi; };
constexpr int N_PHASES = 1 + 12 * DEPTH;

__global__ void __launch_bounds__(NWAVES * 64, 2) mk_fwd(Args args) {
    extern __shared__ __attribute__((aligned(16))) unsigned char lds_raw[];
    LAS unsigned char* lds = (LAS unsigned char*)lds_raw;
    volatile LAS unsigned* MISC = (volatile LAS unsigned*)(lds + MISC_OFF);
    const int tid = threadIdx.x, lane = tid & 63, wave = __builtin_amdgcn_readfirstlane(tid >> 6);
    const int G = gridDim.x, bx = blockIdx.x;
    const int vcu = (G % 8 == 0) ? (bx % 8) * (G / 8) + bx / 8 : bx;
    const int gw = vcu * NWAVES + wave, NGW = G * NWAVES;
    unsigned char* ws = args.ws;
    unsigned* ctl = (unsigned*)(ws + WS_CTL);
    bf16* hbuf = (bf16*)(ws + WS_H); float* xn = (float*)(ws + WS_XN); bf16* act = (bf16*)(ws + WS_ACT); bf16* proj = (bf16*)(ws + WS_PROJ); bf16* ymix = (bf16*)(ws + WS_YMIX);
    if (tid < 32) MISC[tid] = 0u;
    __syncthreads();
    XcdBarrier bar; bar.bar = ctl + CW_BAR; bar.x = 0; bar.st = nullptr;
    if (MK_N_LAUNCHES == 1) bar = xcd_barrier_post(ctl + CW_BAR, MISC + 8, wave);
    const int lo = args.ph_lo, hi = args.ph_hi;
#define IN(k) (lo <= (k) && (k) < hi)
#define SEAM(k) do { if (MK_N_LAUNCHES == 1 && IN((k) + 1)) xcd_barrier(bar, wave); } while (0)

#define CONVERT_RANGE(ib, ie, widx, wstride) convert_range(args.in[6], args.in[7], args.in[9], args.in[15], args.in[17], args.in[18], args.in[5], args.in[8], args.in[16], args.ws + WS_W, (ib), (ie), (widx), (wstride), (LAS float*)(lds + wave * 16640), fresh_lane())
#define CONVERT_IN_TAIL(nbusy, ib, ie) do { int fi_ = (nbusy), ni_ = G_ - fi_; if (ni_ <= 0) { fi_ = 0; ni_ = G_; } \
        const int gb_ = I_GU + l_p * I_LAYER + (ib), ge_ = (I_GU + l_p * I_LAYER + (ie)) < DEPTH * I_LAYER ? (I_GU + l_p * I_LAYER + (ie)) : DEPTH * I_LAYER; \
        if (bx_ >= fi_ && gb_ < ge_) CONVERT_RANGE(gb_, ge_, (bx_ - fi_) * NWAVES + wave, ni_ * NWAVES); } while (0)
    constexpr int CV0 = 0, CV1 = 5914, CV2 = 8294, CV3 = 11864, CV4 = 12730, CV5 = 18644, CV6 = I_LAYER;
    static_assert(I_GU + CV1 >= I_GU + I_DN && I_GU + CV2 >= I_GU + I_DN + I_IN && I_GU + CV3 >= I_GU + I_DN + I_IN + I_OUT && I_GU + CV4 >= 2 * I_GU + I_DN + I_IN + I_OUT && I_GU + CV5 >= I_LAYER, "conversion runs ahead of consumption");
    if (IN(0)) {
        CONVERT_RANGE(0, I_GU, gw, NGW);
        for (int i = gw * 64 + lane; i < DEPTH * (NINP - NIN) * (D / 8); i += NGW * 64) { const int l = i / ((NINP - NIN) * (D / 8)), r = i % ((NINP - NIN) * (D / 8));
            ((v4u*)(ws + WS_W + (size_t)l * W_LAYER + WO_IN + (size_t)NIN * D * 2))[r] = (v4u){0u, 0u, 0u, 0u}; }
        norm_phase<1>(args.in[0], args.in[1], args.in[4], hbuf, args.in[5], xn, nullptr, gw, NGW, lane, nullptr, 0.f, D, G, lds, tid);
        SEAM(0);
    }

#define PH_LOCALS() int tid_p = wave * 64 + fresh_lane(); asm volatile("" : "+v"(tid_p)); const int lane_p = tid_p & 63; int gw_p = gw, ngw_p = NGW, G_ = gridDim.x, bx_ = blockIdx.x, vcu_p = vcu, l_p = l; \
        unsigned char* ws_p = ws; asm volatile("" : "+s"(gw_p), "+s"(ngw_p), "+s"(G_), "+s"(bx_), "+s"(vcu_p), "+s"(l_p), "+s"(ws_p)); \
        unsigned char* wl = ws_p + WS_W + (size_t)l_p * W_LAYER; bf16* hbuf_p = (bf16*)(ws_p + WS_H); float* xn_p = (float*)(ws_p + WS_XN); bf16* act_p = (bf16*)(ws_p + WS_ACT); bf16* proj_p = (bf16*)(ws_p + WS_PROJ); bf16* ymix_p = (bf16*)(ws_p + WS_YMIX); \
        (void)lane_p; (void)gw_p; (void)ngw_p; (void)G_; (void)bx_; (void)vcu_p; (void)wl; (void)hbuf_p; (void)xn_p; (void)act_p; (void)proj_p; (void)ymix_p;
#pragma nounroll
    for (int l = 0; l < DEPTH; ++l) {
        const int pb = 1 + 12 * l;
        if (IN(pb + 0)) { PH_LOCALS();
            pg8::Gemm g{hbuf_p, (const bf16*)(wl + WO_GU1), TP, NGU, D}; pg8::StaticOrder S; S.init(TP, NGU, D, G_, bx_);
            pg8::EpiSwiGLU E{act_p, FF, xn_p};
            pg8::gemm_phase<pg8::EpiSwiGLU, pg8::StaticOrder, true, true>(lds, g, S, E, wave);
            CONVERT_IN_TAIL(S.nwg % G_, CV0, CV1);
            SEAM(pb + 0);
        }
        if (IN(pb + 1)) { PH_LOCALS();
            pg8::Gemm g{act_p, (const bf16*)(wl + WO_DN1), TP, D, FF}; pg8::TailSplitOrder<TSP> S; S.init(TP, D, FF, G_, bx_);
            pg8::EpiResid E{hbuf_p, D, 0.5f, (float*)(ws_p + WS_SLAB)};
            pg8::gemm_phase<pg8::EpiResid, pg8::TailSplitOrder<TSP>, true, true>(lds, g, S, E, wave);
            CONVERT_IN_TAIL(S.ntail() * TSP, CV1, CV2);
            SEAM(pb + 1);
        }
        if (IN(pb + 2)) { PH_LOCALS(); norm_phase<0>(nullptr, nullptr, nullptr, hbuf_p, args.in[8] + (size_t)l_p * D, xn_p, nullptr, gw_p, ngw_p, lane_p, (const float*)(ws_p + WS_SLAB), 0.5f, FF, G_, lds, tid_p); SEAM(pb + 2); }
        if (IN(pb + 3)) { PH_LOCALS();
            pg8::Gemm g{hbuf_p, (const bf16*)(wl + WO_IN), TP, NINP, D}; pg8::StaticOrder S; S.init(TP, NINP, D, G_, bx_);
            pg8::EpiBf16 E{proj_p, NINP, xn_p};
            pg8::gemm_phase<pg8::EpiBf16, pg8::StaticOrder, true, true>(lds, g, S, E, wave);
            CONVERT_IN_TAIL(S.nwg % G_, CV2, CV3);
            SEAM(pb + 3);
        }
        if (IN(pb + 4)) { PH_LOCALS();
            if (G_ <= 32) conv_phase(proj_p, ymix_p, args.in[10] + (size_t)l_p * 3 * DCONV, args.in[11] + (size_t)l_p * DCONV, args.in[2] + (size_t)l_p * 128 * 2 * DCONV, args.out, l_p, gw_p, ngw_p, lane_p);
            else if (vcu_p >= 16) conv_phase(proj_p, ymix_p, args.in[10] + (size_t)l_p * 3 * DCONV, args.in[11] + (size_t)l_p * DCONV, args.in[2] + (size_t)l_p * 128 * 2 * DCONV, args.out, l_p, gw_p - 16 * NWAVES, ngw_p - 16 * NWAVES, lane_p);
            const GAS float* fw2 = (const GAS float*)args.in[12] + (size_t)l_p * GRANK * 512; const GAS float* fb = (const GAS float*)args.in[13] + (size_t)l_p * 512; const GAS float* gg = (const GAS float*)args.in[14] + (size_t)l_p * GDV;
            for (int it = vcu_p; it < 1040; it += G_) {
                const bool isp = it >= 512; const int j = isp ? it - 512 : it;
                const int bh = isp ? j / 33 : j, c = isp ? j - bh * 33 : 0, bi = bh >> 2, hd = bh & 3;
                if (!isp) gla_sample_item(lds, (const GAS bf16*)proj_p, (GAS bf16*)ymix_p, fw2, fb, gg, hd, bi, (const GAS float*)args.in[3] + ((size_t)l_p * 512 + bh) * GDK * GDV, (GAS float*)args.out + O_GS + ((size_t)l_p * 512 + bh) * GDK * GDV, wave);
                else gla_item_mfma(lds, (const GAS bf16*)proj_p, (GAS bf16*)ymix_p, fw2, fb, gg, hd, true, bi, c, nullptr, nullptr, wave,
                              (GAS bf16*)(ws_p + WS_GQS) + (size_t)j * 8192, (GAS bf16*)(ws_p + WS_GPL) + (size_t)j * 4096, (GAS float*)(ws_p + WS_GEBL) + (size_t)j * 128, (GAS float*)((GAS bf16*)(ws_p + WS_GU) + (size_t)j * 32768));
            }
            SEAM(pb + 4);
        }
        if (IN(pb + 5)) { PH_LOCALS();
            gla_scan_phase((const GAS float*)(ws_p + WS_GU), (const GAS float*)(ws_p + WS_GEBL), (GAS bf16*)(ws_p + WS_GS), (GAS float*)args.out + O_GP + (size_t)l_p * 16 * GDK * GDV, vcu_p * (NWAVES * 64) + tid_p, G_ * (NWAVES * 64));
            SEAM(pb + 5);
        }
        if (IN(pb + 6)) { PH_LOCALS();
            const GAS float* gg = (const GAS float*)args.in[14] + (size_t)l_p * GDV;
            for (int it = vcu_p; it < 528; it += G_) { const int bh = it < 512 ? (it >> 5) : it - 512, c = it < 512 ? 1 + (it & 31) : 0, j = bh * 33 + c;
                gla_passC_item(lds, (const GAS bf16*)proj_p, (GAS bf16*)ymix_p, gg, bh & 3, bh >> 2, c, wave,
                               (const GAS bf16*)(ws_p + WS_GQS) + (size_t)j * 8192, (const GAS bf16*)(ws_p + WS_GPL) + (size_t)j * 4096, (const GAS bf16*)(ws_p + WS_GS) + (size_t)j * 32768); }
            SEAM(pb + 6);
        }
        if (IN(pb + 7)) { PH_LOCALS();
            pg8::Gemm g{ymix_p, (const bf16*)(wl + WO_OUT), TP, D, D}; pg8::TailSplitOrder<TSP> S; S.init(TP, D, D, G_, bx_);
            pg8::EpiResid E{hbuf_p, D, 1.0f, (float*)(ws_p + WS_SLAB)};
            pg8::gemm_phase<pg8::EpiResid, pg8::TailSplitOrder<TSP>, true, true>(lds, g, S, E, wave);
            CONVERT_IN_TAIL(S.ntail() * TSP, CV3, CV4);
            SEAM(pb + 7);
        }
        if (IN(pb + 8)) { PH_LOCALS(); norm_phase<0>(nullptr, nullptr, nullptr, hbuf_p, args.in[16] + (size_t)l_p * D, xn_p, nullptr, gw_p, ngw_p, lane_p, (const float*)(ws_p + WS_SLAB), 1.0f, D, G_, lds, tid_p); SEAM(pb + 8); }
        if (IN(pb + 9)) { PH_LOCALS();
            pg8::Gemm g{hbuf_p, (const bf16*)(wl + WO_GU2), TP, NGU, D}; pg8::StaticOrder S; S.init(TP, NGU, D, G_, bx_);
            pg8::EpiSwiGLU E{act_p, FF, xn_p};
            pg8::gemm_phase<pg8::EpiSwiGLU, pg8::StaticOrder, true, true>(lds, g, S, E, wave);
            CONVERT_IN_TAIL(S.nwg % G_, CV4, CV5);
            SEAM(pb + 9);
        }
        if (IN(pb + 10)) { PH_LOCALS();
            pg8::Gemm g{act_p, (const bf16*)(wl + WO_DN2), TP, D, FF}; pg8::TailSplitOrder<TSP> S; S.init(TP, D, FF, G_, bx_);
            pg8::EpiResid E{hbuf_p, D, 0.5f, (float*)(ws_p + WS_SLAB)};
            pg8::gemm_phase<pg8::EpiResid, pg8::TailSplitOrder<TSP>, true, true>(lds, g, S, E, wave);
            CONVERT_IN_TAIL(S.ntail() * TSP, CV5, CV6);
            SEAM(pb + 10);
        }
        if (IN(pb + 11)) { PH_LOCALS();
            if (l_p + 1 < DEPTH) norm_phase<0>(nullptr, nullptr, nullptr, hbuf_p, args.in[5] + (size_t)(l_p + 1) * D, xn_p, nullptr, gw_p, ngw_p, lane_p, (const float*)(ws_p + WS_SLAB), 0.5f, FF, G_, lds, tid_p);
            else norm_phase<2>(nullptr, nullptr, nullptr, hbuf_p, args.in[19], nullptr, args.out, gw_p, ngw_p, lane_p, (const float*)(ws_p + WS_SLAB), 0.5f, FF, G_, lds, tid_p);
            SEAM(pb + 11);
        }
    }
#undef PH_LOCALS
#undef CONVERT_RANGE
#undef CONVERT_IN_TAIL
#undef IN
#undef SEAM
}

extern "C" void kernel_launch(void* const* d_in, const int* in_sizes, int n_in, void* d_out, int out_size, void* d_ws, size_t ws_size, hipStream_t stream) {
    static int grid = 0;
    if (grid == 0) {
        if (n_in != 20 || (size_t)out_size != O_END || ws_size < WS_END) { fprintf(stderr, "kernel_launch: unexpected shapes (n_in %d, out %d, ws %zu); nothing launched\n", n_in, out_size, ws_size); grid = -1; return; }
        int dev = 0, cus = 0, per_cu = 0;
        if (hipGetDevice(&dev) != hipSuccess || hipDeviceGetAttribute(&cus, hipDeviceAttributeMultiprocessorCount, dev) != hipSuccess) { grid = -1; return; }
        if (hipFuncSetAttribute((const void*)mk_fwd, hipFuncAttributeMaxDynamicSharedMemorySize, LDS_BYTES) != hipSuccess) { fprintf(stderr, "kernel_launch: hipFuncSetAttribute failed\n"); grid = -1; return; }
        if (hipOccupancyMaxActiveBlocksPerMultiprocessor(&per_cu, (const void*)mk_fwd, NWAVES * 64, LDS_BYTES) != hipSuccess || per_cu < 1)
            fprintf(stderr, "kernel_launch: occupancy query reports %d workgroups per CU\n", per_cu);
        (void)hipGetLastError();
        grid = cus;
        if (grid < 32) grid = 32;
    }
    if (grid < 0) return;
    (void)hipMemsetAsync((char*)d_ws + WS_CTL, 0, CTL_ZERO_BYTES, stream);
    Args a{};
    for (int i = 0; i < 20; ++i) a.in[i] = (const float*)d_in[i];
    a.out = (float*)d_out; a.ws = (unsigned char*)d_ws;
    if (MK_N_LAUNCHES == 1) {
        a.ph_lo = 0; a.ph_hi = N_PHASES;
        hipLaunchKernelGGL(mk_fwd, dim3(grid), dim3(NWAVES * 64), LDS_BYTES, stream, a);
    } else {
        for (int p = 0; p < N_PHASES; ++p) { a.ph_lo = p; a.ph_hi = p + 1; hipLaunchKernelGGL(mk_fwd, dim3(grid), dim3(NWAVES * 64), LDS_BYTES, stream, a); }
    }
}
```
